# Optimizing an MI355X kernel written in HIP

```python
import math
import jax, jax.numpy as jnp
from jax import lax
import numpy as np

D_MODEL = 1024
BATCH = 4
SEQ = 4096
DEPTH = 2

N_MEM = 256
Q_BLOCK = 128
EPS = 1e-6
LRU_WIDTH = D_MODEL // 2
LRU_BLOCKS = 8
LRU_BLOCK_DIM = LRU_WIDTH // LRU_BLOCKS
CONV_WIDTH = 4
LRU_C = 8.0
FOX_HEADS = 8
FOX_HEAD_DIM = (D_MODEL // 2) // FOX_HEADS
FOX_WIDTH = FOX_HEADS * FOX_HEAD_DIM
EVEN_SPLITS = [LRU_WIDTH, LRU_WIDTH, FOX_WIDTH, FOX_WIDTH, FOX_WIDTH, FOX_HEADS]
EVEN_IN = sum(EVEN_SPLITS)
EVEN_MIX = LRU_WIDTH + FOX_WIDTH
DIFF_HEADS = 8
DIFF_HEAD_DIM = D_MODEL // (2 * DIFF_HEADS)
DIFF_V_DIM = 2 * DIFF_HEAD_DIM
DIFF_WIDTH = DIFF_HEADS * DIFF_V_DIM
ODD_IN = 3 * DIFF_WIDTH
XATTN_HEADS = 4
XATTN_HEAD_DIM = D_MODEL // XATTN_HEADS
D_FF = 4 * D_MODEL
N_EVEN = (DEPTH + 1) // 2
N_ODD = DEPTH // 2

kernel_name = "hybrid_rglru_fox_diffattn_trunk"


def _rmsnorm(x, g):
    xf = x.astype(jnp.float32)
    y = xf * lax.rsqrt(jnp.mean(xf * xf, axis=-1, keepdims=True) + EPS)
    return (y * g.astype(jnp.float32)).astype(x.dtype)


def _sweep_query_blocks(block_fn, seq_len):
    starts = jnp.arange(seq_len // Q_BLOCK) * Q_BLOCK
    out = lax.map(block_fn, starts)
    n, b, h, qb, dv = out.shape
    return out.transpose(1, 2, 0, 3, 4).reshape(b, h, n * qb, dv)


def _rglru_group(xb, gb, conv_w, conv_b, w_r, b_r, w_i, b_i, lam):
    b, s, w = xb.shape
    xp = jnp.pad(xb, ((0, 0), (CONV_WIDTH - 1, 0), (0, 0)))
    xc = conv_b + sum(xp[:, k:k + s] * conv_w[k] for k in range(CONV_WIDTH))
    xg = xc.reshape(b, s, LRU_BLOCKS, LRU_BLOCK_DIM)
    r = jax.nn.sigmoid(jnp.einsum('bsgi,gij->bsgj', xg, w_r).reshape(b, s, w) + b_r)
    i = jax.nn.sigmoid(jnp.einsum('bsgi,gij->bsgj', xg, w_i).reshape(b, s, w) + b_i)
    log_a = LRU_C * r.astype(jnp.float32) * jax.nn.log_sigmoid(lam.astype(jnp.float32))
    a = jnp.exp(log_a)
    u = jnp.sqrt(-jnp.expm1(2.0 * log_a)) * (i * xc).astype(jnp.float32)

    def combine(left, right):
        a1, b1 = left
        a2, b2 = right
        return a1 * a2, a2 * b1 + b2

    _, h = lax.associative_scan(combine, (a, u), axis=1)
    return h.astype(xb.dtype) * jax.nn.gelu(gb)


def _fox_attention(q, k, v, log_f):
    b, s, h, dh = q.shape
    qf = (q.astype(jnp.float32) * dh ** -0.5).transpose(0, 2, 1, 3)
    kf = k.astype(jnp.float32).transpose(0, 2, 1, 3)
    vf = v.astype(jnp.float32).transpose(0, 2, 1, 3)
    cum = jnp.cumsum(log_f.astype(jnp.float32), axis=1).transpose(0, 2, 1)
    k_pos = jnp.arange(s)

    def block(start):
        qb = lax.dynamic_slice_in_dim(qf, start, Q_BLOCK, axis=2)
        cq = lax.dynamic_slice_in_dim(cum, start, Q_BLOCK, axis=2)
        q_pos = start + jnp.arange(Q_BLOCK)
        logits = jnp.einsum('bhqd,bhkd->bhqk', qb, kf) + cq[..., :, None] - cum[..., None, :]
        logits = jnp.where(k_pos[None, :] <= q_pos[:, None], logits, -jnp.inf)
        p = jax.nn.softmax(logits, axis=-1)
        return jnp.einsum('bhqk,bhkd->bhqd', p, vf)

    o = _sweep_query_blocks(block, s)
    return o.transpose(0, 2, 1, 3).reshape(b, s, h * dh).astype(q.dtype)


def _diff_attention(q, k, v, lam, lambda_init, norm_g):
    b, s, h, _, dh = q.shape
    dv = v.shape[-1]
    qf = (q.astype(jnp.float32) * dh ** -0.5).transpose(0, 2, 3, 1, 4)
    kf = k.astype(jnp.float32).transpose(0, 2, 3, 1, 4)
    vf = v.astype(jnp.float32).transpose(0, 2, 1, 3)
    k_pos = jnp.arange(s)

    def block(start):
        qb = lax.dynamic_slice_in_dim(qf, start, Q_BLOCK, axis=3)
        q_pos = start + jnp.arange(Q_BLOCK)
        logits = jnp.einsum('bhcqd,bhckd->bhcqk', qb, kf)
        logits = jnp.where(k_pos[None, :] <= q_pos[:, None], logits, -jnp.inf)
        p = jax.nn.softmax(logits, axis=-1)
        w = p[:, :, 0] - lam * p[:, :, 1]
        return jnp.einsum('bhqk,bhkd->bhqd', w, vf)

    o = _sweep_query_blocks(block, s)
    o = o * lax.rsqrt(jnp.mean(o * o, axis=-1, keepdims=True) + EPS)
    o = o * norm_g.astype(jnp.float32) * (1.0 - lambda_init)
    return o.transpose(0, 2, 1, 3).reshape(b, s, h * dv).astype(q.dtype)


def _memory_cross_attention(xn, mem_n, wq, wkv, wo):
    b, s, d = xn.shape
    m = mem_n.shape[1]
    q = (xn @ wq).reshape(b, s, XATTN_HEADS, XATTN_HEAD_DIM).astype(jnp.float32)
    kv = (mem_n @ wkv).reshape(b, m, 2, XATTN_HEADS, XATTN_HEAD_DIM).astype(jnp.float32)
    logits = jnp.einsum('bshd,bmhd->bhsm', q, kv[:, :, 0]) * XATTN_HEAD_DIM ** -0.5
    p = jax.nn.softmax(logits, axis=-1)
    o = jnp.einsum('bhsm,bmhd->bshd', p, kv[:, :, 1]).reshape(b, s, d).astype(xn.dtype)
    return o @ wo


def _sq_relu_mlp(xn, w_up, w_down):
    return jnp.square(jax.nn.relu(xn @ w_up)) @ w_down


def setup_inputs(seed: int = 0) -> dict:
    key = jax.random.key(seed)
    ks = iter(jax.random.split(key, 40))

    def nrm(shape, fan_in):
        return jax.random.normal(next(ks), shape, jnp.float32) * fan_in ** -0.5

    def gain(shape):
        return 1.0 + 0.02 * jax.random.normal(next(ks), shape, jnp.float32)

    def small(shape, scale=0.02):
        return scale * jax.random.normal(next(ks), shape, jnp.float32)

    u = jax.random.uniform(next(ks), (N_EVEN, LRU_WIDTH), jnp.float32, 0.9, 0.999)
    return {
        "x": jax.random.normal(next(ks), (BATCH, SEQ, D_MODEL), jnp.float32),
        "mem": jax.random.normal(next(ks), (BATCH, N_MEM, D_MODEL), jnp.float32),
        "g_mem": gain((D_MODEL,)),
        "g_final": gain((D_MODEL,)),
        "mix_norm_g": gain((DEPTH, D_MODEL)),
        "xattn_norm_g": gain((DEPTH, D_MODEL)),
        "mlp_norm_g": gain((DEPTH, D_MODEL)),
        "w_in_even": nrm((N_EVEN, D_MODEL, EVEN_IN), D_MODEL),
        "conv_w": nrm((N_EVEN, CONV_WIDTH, LRU_WIDTH), CONV_WIDTH),
        "conv_b": small((N_EVEN, LRU_WIDTH)),
        "w_rgate": nrm((N_EVEN, LRU_BLOCKS, LRU_BLOCK_DIM, LRU_BLOCK_DIM), LRU_BLOCK_DIM),
        "b_rgate": small((N_EVEN, LRU_WIDTH)),
        "w_igate": nrm((N_EVEN, LRU_BLOCKS, LRU_BLOCK_DIM, LRU_BLOCK_DIM), LRU_BLOCK_DIM),
        "b_igate": small((N_EVEN, LRU_WIDTH)),
        "lru_lambda": jnp.log(u) - jnp.log1p(-u),
        "fox_forget_b": 3.0 + small((N_EVEN, FOX_HEADS), 0.1),
        "w_out_even": nrm((N_EVEN, EVEN_MIX, D_MODEL), EVEN_MIX),
        "w_in_odd": nrm((N_ODD, D_MODEL, ODD_IN), D_MODEL),
        "lambda_q1": small((N_ODD, DIFF_HEAD_DIM), 0.1),
        "lambda_k1": small((N_ODD, DIFF_HEAD_DIM), 0.1),
        "lambda_q2": small((N_ODD, DIFF_HEAD_DIM), 0.1),
        "lambda_k2": small((N_ODD, DIFF_HEAD_DIM), 0.1),
        "diff_norm_g": gain((N_ODD, DIFF_V_DIM)),
        "w_out_odd": nrm((N_ODD, DIFF_WIDTH, D_MODEL), DIFF_WIDTH),
        "xattn_wq": nrm((DEPTH, D_MODEL, D_MODEL), D_MODEL),
        "xattn_wkv": nrm((DEPTH, D_MODEL, 2 * D_MODEL), D_MODEL),
        "xattn_wo": nrm((DEPTH, D_MODEL, D_MODEL), D_MODEL),
        "w_up": nrm((DEPTH, D_MODEL, D_FF), D_MODEL),
        "w_down": nrm((DEPTH, D_FF, D_MODEL), D_FF),
    }


def reference(x, mem, g_mem, g_final, mix_norm_g, xattn_norm_g, mlp_norm_g,
              w_in_even, conv_w, conv_b, w_rgate, b_rgate, w_igate, b_igate,
              lru_lambda, fox_forget_b, w_out_even,
              w_in_odd, lambda_q1, lambda_k1, lambda_q2, lambda_k2, diff_norm_g, w_out_odd,
              xattn_wq, xattn_wkv, xattn_wo, w_up, w_down):
    b, s, d = x.shape
    split_at = [int(c) for c in np.cumsum(EVEN_SPLITS)[:-1]]
    mem_n = _rmsnorm(mem, g_mem)
    h = x
    for layer in range(DEPTH):
        i = layer // 2
        hn = _rmsnorm(h, mix_norm_g[layer])
        if layer % 2 == 0:
            z = hn @ w_in_even[i]
            xb, gb, q, k, v, f_logit = jnp.split(z, split_at, axis=-1)
            y_lru = _rglru_group(xb, gb, conv_w[i], conv_b[i], w_rgate[i], b_rgate[i],
                                 w_igate[i], b_igate[i], lru_lambda[i])
            log_f = jax.nn.log_sigmoid((f_logit + fox_forget_b[i]).astype(jnp.float32))
            y_fox = _fox_attention(q.reshape(b, s, FOX_HEADS, FOX_HEAD_DIM),
                                   k.reshape(b, s, FOX_HEADS, FOX_HEAD_DIM),
                                   v.reshape(b, s, FOX_HEADS, FOX_HEAD_DIM), log_f)
            mixed = jnp.concatenate([y_lru, y_fox], axis=-1) @ w_out_even[i]
        else:
            z = hn @ w_in_odd[i]
            q, k, v = jnp.split(z, 3, axis=-1)
            lambda_init = 0.8 - 0.6 * math.exp(-0.3 * layer)
            f32 = jnp.float32
            lam = (jnp.exp(jnp.sum(lambda_q1[i].astype(f32) * lambda_k1[i].astype(f32)))
                   - jnp.exp(jnp.sum(lambda_q2[i].astype(f32) * lambda_k2[i].astype(f32)))
                   + lambda_init)
            y = _diff_attention(q.reshape(b, s, DIFF_HEADS, 2, DIFF_HEAD_DIM),
                                k.reshape(b, s, DIFF_HEADS, 2, DIFF_HEAD_DIM),
                                v.reshape(b, s, DIFF_HEADS, DIFF_V_DIM),
                                lam, lambda_init, diff_norm_g[i])
            mixed = y @ w_out_odd[i]
        h = h + mixed
        h = h + _memory_cross_attention(_rmsnorm(h, xattn_norm_g[layer]), mem_n,
                                        xattn_wq[layer], xattn_wkv[layer], xattn_wo[layer])
        h = h + _sq_relu_mlp(_rmsnorm(h, mlp_norm_g[layer]), w_up[layer], w_down[layer])
    return _rmsnorm(h, g_final)
```

```cpp
#include <hip/hip_runtime.h>
#include <hip/hip_cooperative_groups.h>
#include <cstdio>
#include <cstdint>
namespace cg = cooperative_groups;
namespace pg8 {
#define PG8_LAS __attribute__((address_space(3)))
typedef unsigned short bf16_t;
typedef short bf16x8 __attribute__((ext_vector_type(8)));
typedef float f32x4 __attribute__((ext_vector_type(4)));
typedef unsigned u32x4 __attribute__((ext_vector_type(4)));
constexpr int BM = 256, BK = 64, HALF = 128, HTB = HALF * BK * 2  , STAGE_BYTES = 8 * HTB, NXCD = 8, WGM = 8;

__host__ __device__ __forceinline__ int lds_byte(int r, int c) { const int st = (r >> 4) * 2 + (c >> 5), rr = r & 15, cc = c & 31, ob = rr * 64 + cc * 2; return st * 1024 + (ob ^ (((ob >> 9) & 1) << 5)); }
__host__ __device__ __forceinline__ void stage_rc(int b, int& R, int& C) { const int st = b / 1024, sb = b % 1024, swz = sb ^ (((sb >> 9) & 1) << 5); R = (st >> 1) * 16 + swz / 64; C = (st & 1) * 32 + (swz % 64) / 2; }
__host__ __device__ __forceinline__ int perm32(int rho) { const int n = rho >> 4, i = rho & 15; return 8 * (i >> 2) + 4 * n + (i & 3); }

struct Unit { int pm, pn; };
struct Gemm { const bf16_t* A; const bf16_t* Bt; int M, N, K, lda, ldb; };

struct StaticOrder {
    int nM, nN, nwg, G, c;
    __host__ __device__ void init(int M, int N, int G_, int c_) { nM = M / BM; nN = N / BM; nwg = nM * nN; G = G_; c = c_; }
    __host__ __device__ bool next(int i, Unit& u) const {
        const long L = (long)i * G + c; if (L >= nwg) return false;
        int wgid = (int)L; { const int q = nwg / NXCD, r = nwg % NXCD, xcd = wgid % NXCD, off = wgid / NXCD; wgid = (xcd < r ? xcd * (q + 1) : r * (q + 1) + (xcd - r) * q) + off; }
        const int nig = WGM * nN, gid = wgid / nig, fm = gid * WGM, gsz = (nM - fm) < WGM ? (nM - fm) : WGM;
        u.pm = fm + ((wgid % nig) % gsz); u.pn = (wgid % nig) / gsz; return true;
    }
    __device__ __forceinline__ void a_ready(const Unit&) const {}
    __device__ __forceinline__ void done(const Unit&) const {}
};

__device__ __forceinline__ unsigned cvt_pk_bf16(float lo, float hi) { unsigned r; asm volatile("v_cvt_pk_bf16_f32 %0, %1, %2" : "=v"(r) : "v"(lo), "v"(hi)); return r; }
typedef float f32x2 __attribute__((ext_vector_type(2)));
template <class Epi, class Sched, bool ALIGN_EPI = false, bool SP2 = false>
__device__ __forceinline__ void gemm_phase(PG8_LAS unsigned char* lds, const Gemm g, const Sched& S, const Epi& E) {
    int tid_ = threadIdx.x; asm volatile("" : "+v"(tid_)); const int tid = tid_, wid = __builtin_amdgcn_readfirstlane(tid >> 6), lane = tid & 63, wr = wid >> 2, wc = wid & 3, fr = lane & 15, fq = lane >> 4;
    const int K = g.K, nt = K / BK, lda = g.lda ? g.lda : g.K, ldb = g.ldb ? g.ldb : g.K;
    unsigned voffA[2], voffB[2];
#pragma unroll
    for (int i = 0; i < 2; ++i) { int R, C; stage_rc(tid * 16 + i * 8192, R, C); const int Rb = Epi::PERM ? ((R & ~31) + perm32(R & 31)) : R;
        voffA[i] = (unsigned)(R * lda + C) * 2u; voffB[i] = (unsigned)(Rb * ldb + C) * 2u; }
    const size_t kstep = (size_t)(BK * 2);
    const size_t hstepA = (size_t)HALF * lda * 2, hstepB = (size_t)HALF * ldb * 2;
    const size_t tstepA = 2 * hstepA, tstepB = 2 * hstepB;
    const unsigned ldsw = (unsigned)wid * 1024u;
    const int aoff = lds_byte(wr * 64 + fr, fq * 8), boff = lds_byte(wc * 32 + fr, fq * 8);
#define PG8_SA(b, h) (((b) * 2 + (h)) * HTB)
#define PG8_SB(b, h) ((4 + (b) * 2 + (h)) * HTB)
#define PG8_STAGE(bufoff, gbase, voff) do { _Pragma("unroll") for (int _i = 0; _i < 2; ++_i) \
        __builtin_amdgcn_global_load_lds((const unsigned*)((const char*)(gbase) + (voff)[_i]), (PG8_LAS unsigned*)(lds + (bufoff) + ldsw + _i * 8192), 16, 0, 0); } while (0)
#define PG8_LDA(dst, b, h) do { _Pragma("unroll") for (int m = 0; m < 4; ++m) _Pragma("unroll") for (int k = 0; k < 2; ++k) dst[m][k] = *(const PG8_LAS bf16x8*)(lds + PG8_SA(b, h) + aoff + m * 2048 + k * 1024); } while (0)
#define PG8_LDB(dst, b, h) do { _Pragma("unroll") for (int n = 0; n < 2; ++n) _Pragma("unroll") for (int k = 0; k < 2; ++k) dst[n][k] = *(const PG8_LAS bf16x8*)(lds + PG8_SB(b, h) + boff + n * 2048 + k * 1024); } while (0)
#define PG8_MMA(ai, bj, At, Bt) do { __builtin_amdgcn_s_setprio(1); _Pragma("unroll") for (int m = 0; m < 4; ++m) _Pragma("unroll") for (int n = 0; n < 2; ++n) _Pragma("unroll") for (int k = 0; k < 2; ++k) \
        acc[ai][bj][m][n] = __builtin_amdgcn_mfma_f32_16x16x32_bf16(Bt[n][k], At[m][k], acc[ai][bj][m][n], 0, 0, 0); __builtin_amdgcn_s_setprio(0); } while (0)
#define PG8_WAIT_V(n) asm volatile("s_waitcnt vmcnt(" #n ")" ::: "memory")
#define PG8_WAIT_L(n) asm volatile("s_waitcnt lgkmcnt(" #n ")" ::: "memory")
#define PG8_BAR __builtin_amdgcn_s_barrier()
#define PG8_SCHED __builtin_amdgcn_sched_barrier(0)
    Unit cur, nxt; int ui = 0;
    if (!S.next(0, cur)) return;
    f32x4 acc[2][2][4][2];
#pragma unroll
    for (int a = 0; a < 2; ++a)
#pragma unroll
        for (int b = 0; b < 2; ++b)
#pragma unroll
            for (int m = 0; m < 4; ++m)
#pragma unroll
                for (int n = 0; n < 2; ++n) acc[a][b][m][n] = (f32x4){0.f, 0.f, 0.f, 0.f};
    bf16x8 At[4][2], B0[2][2], B1[2][2];
    const char* cA = (const char*)g.A + (size_t)cur.pm * tstepA; const char* cB = (const char*)g.Bt + (size_t)cur.pn * tstepB;
    S.a_ready(cur);
    if constexpr (SP2) {
        PG8_STAGE(PG8_SB(0, 0), cB, voffB); PG8_STAGE(PG8_SB(0, 1), cB + hstepB, voffB); PG8_STAGE(PG8_SA(0, 0), cA, voffA); PG8_STAGE(PG8_SA(0, 1), cA + hstepA, voffA);
        if (wr == 1) PG8_BAR;
        PG8_WAIT_V(2); PG8_BAR;
        PG8_STAGE(PG8_SB(1, 0), cB + kstep, voffB); PG8_STAGE(PG8_SA(1, 0), cA + kstep, voffA); PG8_STAGE(PG8_SB(1, 1), cB + hstepB + kstep, voffB);
        PG8_WAIT_V(6); PG8_BAR;
    } else {
        PG8_STAGE(PG8_SB(0, 0), cB, voffB); PG8_STAGE(PG8_SA(0, 0), cA, voffA); PG8_STAGE(PG8_SB(0, 1), cB + hstepB, voffB); PG8_STAGE(PG8_SA(0, 1), cA + hstepA, voffA);
        if (wr == 1) PG8_BAR;
        PG8_WAIT_V(4); PG8_BAR;
        PG8_STAGE(PG8_SB(1, 0), cB + kstep, voffB); PG8_STAGE(PG8_SA(1, 0), cA + kstep, voffA); PG8_STAGE(PG8_SB(1, 1), cB + hstepB + kstep, voffB);
        PG8_WAIT_V(6); PG8_BAR;
    }
    for (;;) {
        const bool has_next = S.next(ui + 1, nxt);
        const char* nA = has_next ? (const char*)g.A + (size_t)nxt.pm * tstepA : cA; const char* nB = has_next ? (const char*)g.Bt + (size_t)nxt.pn * tstepB : cB;
        for (int t = 0; t < nt; t += 2) {
            const bool last = (t == nt - 2);
            const char* a1 = cA + (size_t)(t + 1) * kstep;
            const char* a2 = last ? nA : cA + (size_t)(t + 2) * kstep; const char* b2 = last ? nB : cB + (size_t)(t + 2) * kstep;
            const char* a3 = a2 + kstep; const char* b3 = b2 + kstep;
            if (last && has_next) S.a_ready(nxt);
            if constexpr (SP2) {
            PG8_LDB(B0, 0, 0); PG8_LDB(B1, 0, 1); PG8_SCHED; PG8_LDA(At, 0, 0); PG8_STAGE(PG8_SA(1, 1), a1 + hstepA, voffA);
            PG8_WAIT_V(8); PG8_WAIT_L(0); PG8_BAR; PG8_MMA(0, 0, At, B0); PG8_MMA(0, 1, At, B1); PG8_BAR; PG8_SCHED;
            PG8_LDA(At, 0, 1); PG8_STAGE(PG8_SB(0, 0), b2, voffB); PG8_STAGE(PG8_SB(0, 1), b2 + hstepB, voffB); PG8_STAGE(PG8_SA(0, 0), a2, voffA);
            PG8_WAIT_V(8); PG8_WAIT_L(0); PG8_BAR; PG8_MMA(1, 0, At, B0); PG8_MMA(1, 1, At, B1); PG8_BAR; PG8_SCHED;
            PG8_LDB(B0, 1, 0); PG8_LDB(B1, 1, 1); PG8_SCHED; PG8_LDA(At, 1, 0); PG8_STAGE(PG8_SA(0, 1), a2 + hstepA, voffA);
            PG8_WAIT_V(8); PG8_WAIT_L(0); PG8_BAR; PG8_MMA(0, 0, At, B0); PG8_MMA(0, 1, At, B1); PG8_BAR; PG8_SCHED;
            PG8_LDA(At, 1, 1); PG8_STAGE(PG8_SB(1, 0), b3, voffB); PG8_STAGE(PG8_SB(1, 1), b3 + hstepB, voffB); PG8_STAGE(PG8_SA(1, 0), a3, voffA);
            PG8_WAIT_V(8); PG8_WAIT_L(0); PG8_BAR; PG8_MMA(1, 0, At, B0); PG8_MMA(1, 1, At, B1); PG8_BAR; PG8_SCHED;
            } else {
            PG8_LDB(B0, 0, 0); PG8_SCHED; PG8_LDA(At, 0, 0); PG8_STAGE(PG8_SA(1, 1), a1 + hstepA, voffA);
            PG8_WAIT_L(8); PG8_BAR; PG8_WAIT_L(0); PG8_MMA(0, 0, At, B0); PG8_BAR; PG8_SCHED;
            PG8_LDB(B1, 0, 1); PG8_STAGE(PG8_SB(0, 0), b2, voffB);
            PG8_BAR; PG8_WAIT_L(0); PG8_MMA(0, 1, At, B1); PG8_BAR;
            PG8_LDA(At, 0, 1); PG8_STAGE(PG8_SA(0, 0), a2, voffA);
            PG8_BAR; PG8_WAIT_L(0); PG8_MMA(1, 0, At, B0); PG8_BAR; PG8_SCHED;
            PG8_STAGE(PG8_SB(0, 1), b2 + hstepB, voffB);
            PG8_WAIT_V(6); PG8_BAR; PG8_MMA(1, 1, At, B1); PG8_BAR;
            PG8_LDB(B0, 1, 0); PG8_SCHED; PG8_LDA(At, 1, 0); PG8_STAGE(PG8_SA(0, 1), a2 + hstepA, voffA);
            PG8_WAIT_L(8); PG8_BAR; PG8_WAIT_L(0); PG8_MMA(0, 0, At, B0); PG8_BAR; PG8_SCHED;
            PG8_LDB(B1, 1, 1); PG8_STAGE(PG8_SB(1, 0), b3, voffB);
            PG8_BAR; PG8_WAIT_L(0); PG8_MMA(0, 1, At, B1); PG8_BAR;
            PG8_LDA(At, 1, 1); PG8_STAGE(PG8_SA(1, 0), a3, voffA);
            PG8_BAR; PG8_WAIT_L(0); PG8_MMA(1, 0, At, B0); PG8_BAR; PG8_SCHED;
            PG8_STAGE(PG8_SB(1, 1), b3 + hstepB, voffB);
            PG8_WAIT_V(6); PG8_BAR; PG8_MMA(1, 1, At, B1); PG8_BAR;
            }
        }
        if constexpr (ALIGN_EPI) { if (wr == 0) PG8_BAR; }
        if constexpr (!Epi::AFTER_DRAIN) { E(acc, cur, wr, wc, fr, fq); S.done(cur); }
        if (!has_next) break;
#pragma unroll
        for (int a = 0; a < 2; ++a)
#pragma unroll
            for (int b = 0; b < 2; ++b)
#pragma unroll
                for (int m = 0; m < 4; ++m)
#pragma unroll
                    for (int n = 0; n < 2; ++n) acc[a][b][m][n] = (f32x4){0.f, 0.f, 0.f, 0.f};
        cur = nxt; cA = nA; cB = nB; ++ui;
        if constexpr (ALIGN_EPI) { if (wr == 1) PG8_BAR; }
    }
    PG8_WAIT_V(0);
    if constexpr (!ALIGN_EPI) { if (wr == 0) PG8_BAR; }
    PG8_BAR;
    if constexpr (Epi::AFTER_DRAIN) { E.fused(acc, cur, wr, wc, fr, fq, lds, wid, lane); S.done(cur); }
#undef PG8_SA
#undef PG8_SB
#undef PG8_STAGE
#undef PG8_LDA
#undef PG8_LDB
#undef PG8_MMA
#undef PG8_WAIT_V
#undef PG8_WAIT_L
#undef PG8_BAR
#undef PG8_SCHED
}
}

using pg8::bf16_t; using pg8::bf16x8; using pg8::f32x4; using pg8::u32x4;
typedef float f32x16 __attribute__((ext_vector_type(16)));
typedef short s16x4 __attribute__((ext_vector_type(4)));
typedef unsigned u32x2 __attribute__((ext_vector_type(2)));
typedef float f32x2_t __attribute__((ext_vector_type(2)));
typedef __bf16 bf16x2_t __attribute__((ext_vector_type(2)));
#define LAS __attribute__((address_space(3)))
#define DI __device__ __forceinline__
#define MFMA32(a, b, c) __builtin_amdgcn_mfma_f32_32x32x16_bf16((a), (b), (c), 0, 0, 0)

#ifndef PHMASK
#define PHMASK 0xFFFFFFFFu
#endif
#define PH_ON(x) (((PHMASK) >> (x)) & 1u)
#ifndef REPEAT_PH
#define REPEAT_PH (-1)
#endif
#ifndef EXTRA_SYNC
#define EXTRA_SYNC 0
#endif
#ifndef USE_CG_FIRST
#define USE_CG_FIRST 1
#endif
#ifndef MK_ONE_LAUNCH
#define MK_ONE_LAUNCH 1
#endif

constexpr int D = 1024, SEQ = 4096, M = 16384, MMEM = 1024, FF = 4096;
constexpr int EIN = 2568, EINP = 2560, OIN = 3072;
constexpr float EPS = 1e-6f, LOG2E = 1.4426950408889634f;
constexpr int NPHASE = 19;
constexpr size_t MiB = 1u << 20;
constexpr size_t W_INE = 0, W_OUTE = 5 * MiB, W_INO = 7 * MiB, W_OUTO = 13 * MiB, W_Q = 15 * MiB, W_KV = 19 * MiB, W_O = 27 * MiB, W_UP = 31 * MiB, W_DN = 47 * MiB;
constexpr size_t W_GATE = 63 * MiB;
constexpr size_t A_HB = 64 * MiB;
constexpr size_t A_Z = 96 * MiB;
constexpr size_t A_XQ = 96 * MiB, A_XO = 128 * MiB;
constexpr size_t A_FF = 96 * MiB;
constexpr size_t A_Y = 192 * MiB;
constexpr size_t A_MEMN = 224 * MiB;
constexpr size_t A_KV = 226 * MiB;
constexpr size_t A_SLOT = 234 * MiB;
constexpr size_t A_LF = 235 * MiB;
constexpr size_t A_CARRY = 236 * MiB;
constexpr size_t A_KMAX = 238 * MiB + 32768;
constexpr size_t A_LSL = 237 * MiB;
constexpr size_t A_BAR = 238 * MiB;
constexpr int LDS_BYTES = 155648, LDS_BARST = 155648 - 64;

DI float bf2f(unsigned short u) { return __uint_as_float((unsigned)u << 16); }
DI unsigned pk2(float lo, float hi) { f32x2_t v = {lo, hi}; bf16x2_t b = __builtin_convertvector(v, bf16x2_t); return __builtin_bit_cast(unsigned, b); }
DI int crow(int i, int h) { return (i & 3) + 8 * (i >> 2) + 4 * h; }
DI float wave_sum(float v) {
#pragma unroll
    for (int o = 1; o < 64; o <<= 1) v += __shfl_xor(v, o);
    return v;
}
DI float ex2(float x) { return __builtin_amdgcn_exp2f(x); }
DI float fsigmoid(float x) { return __builtin_amdgcn_rcpf(1.f + ex2(-LOG2E * x)); }
DI float gelu_tanh(float x) { const float y = 0.7978845608028654f * (x + 0.044715f * x * x * x); const float e = ex2((2.f * LOG2E) * y); const float t = 1.f - 2.f * __builtin_amdgcn_rcpf(e + 1.f); return 0.5f * x * (1.f + t); }
DI float log_sigmoid(float x) { return fminf(x, 0.f) - log1pf(__expf(-fabsf(x))); }
DI s16x4 vtr(const LAS unsigned char* p) { return __builtin_bit_cast(s16x4, __builtin_amdgcn_ds_read_tr16_b64_v4i16((LAS s16x4*)p)); }
DI bf16x8 cat8(s16x4 lo, s16x4 hi) { return (bf16x8){lo[0], lo[1], lo[2], lo[3], hi[0], hi[1], hi[2], hi[3]}; }

struct Params { const float* in[29]; float* out; unsigned char* ws; int ph_lo, ph_hi; };
typedef const Params __attribute__((address_space(4)))* KP;

template <int ACT> struct EpiScale {
    static constexpr bool PERM = true, AFTER_DRAIN = false;
    bf16_t* O; int ldc; const float* slots; float cscale; int cs_lo, cs_hi;
    __device__ __forceinline__ void operator()(const f32x4 (&acc)[2][2][4][2], const pg8::Unit& u, int wr, int wc, int fr, int fq) const {
        const int row0 = u.pm * 256 + wr * 64 + fr, col0 = u.pn * 256 + wc * 32 + 8 * fq;
        const float sc = (u.pn >= cs_lo && u.pn < cs_hi) ? cscale : 1.f;
#pragma unroll
        for (int ai = 0; ai < 2; ++ai) {
            float rs[4];
            if (slots) {
                f32x4 sv[4];
#pragma unroll
                for (int m = 0; m < 4; ++m) sv[m] = *(const f32x4*)(slots + (size_t)(row0 + ai * 128 + m * 16) * 16 + 4 * fq);
                __builtin_amdgcn_sched_barrier(0);
#pragma unroll
                for (int m = 0; m < 4; ++m) { float ss = (sv[m][0] + sv[m][1]) + (sv[m][2] + sv[m][3]); ss += __shfl_xor(ss, 16); ss += __shfl_xor(ss, 32);
                    rs[m] = rsqrtf(ss * (1.f / 1024.f) + EPS); }
            } else {
#pragma unroll
                for (int m = 0; m < 4; ++m) rs[m] = 1.f;
            }
#pragma unroll
            for (int m = 0; m < 4; ++m) {
                const int row = row0 + ai * 128 + m * 16; float r_ = rs[m];
                if (ACT == 0) r_ *= sc;
                bf16_t* rowp = O + (size_t)row * ldc + col0;
#pragma unroll
                for (int bj = 0; bj < 2; ++bj) { f32x4 v0 = acc[ai][bj][m][0] * r_, v1 = acc[ai][bj][m][1] * r_;
                    if (ACT == 1) {
#pragma unroll
                        for (int e = 0; e < 4; ++e) { const float a0 = fmaxf(v0[e], 0.f), a1 = fmaxf(v1[e], 0.f); v0[e] = a0 * a0; v1[e] = a1 * a1; } }
                    u32x4 w; w.x = pk2(v0[0], v0[1]); w.y = pk2(v0[2], v0[3]); w.z = pk2(v1[0], v1[1]); w.w = pk2(v1[2], v1[3]);
                    *(u32x4*)(rowp + bj * 128) = w; }
            }
        }
    }
};
struct EpiSoftmaxP {
    static constexpr bool PERM = true, AFTER_DRAIN = true;
    const float* slots; float cscale; bf16_t* P;
    __device__ __forceinline__ void fused(f32x4 (&acc)[2][2][4][2], const pg8::Unit& u, int wr, int wc, int fr, int fq, PG8_LAS unsigned char* lds, int, int) const {
        PG8_LAS float* X1 = (PG8_LAS float*)lds; PG8_LAS float* X2 = X1 + 1024;
        const int rl0 = wr * 64 + fr;
#pragma unroll
        for (int ai = 0; ai < 2; ++ai)
#pragma unroll
            for (int m = 0; m < 4; ++m) {
                const f32x4 a = *(const f32x4*)(slots + (size_t)(u.pm * 256 + rl0 + ai * 128 + m * 16) * 16 + 4 * fq);
                float ss = (a[0] + a[1]) + (a[2] + a[3]); ss += __shfl_xor(ss, 16); ss += __shfl_xor(ss, 32);
                const float rs = rsqrtf(ss * (1.f / 1024.f) + EPS) * cscale; float mx = -INFINITY;
#pragma unroll
                for (int bj = 0; bj < 2; ++bj)
#pragma unroll
                    for (int n = 0; n < 2; ++n) { acc[ai][bj][m][n] *= rs; const f32x4 v = acc[ai][bj][m][n]; mx = fmaxf(mx, fmaxf(fmaxf(v[0], v[1]), fmaxf(v[2], v[3]))); }
                mx = fmaxf(mx, __shfl_xor(mx, 16)); mx = fmaxf(mx, __shfl_xor(mx, 32));
                if (fq == 0) X1[(rl0 + ai * 128 + m * 16) * 4 + wc] = mx;
            }
        asm volatile("s_waitcnt lgkmcnt(0)" ::: "memory"); __builtin_amdgcn_s_barrier(); asm volatile("" ::: "memory");
#pragma unroll
        for (int ai = 0; ai < 2; ++ai)
#pragma unroll
            for (int m = 0; m < 4; ++m) {
                const int rl = rl0 + ai * 128 + m * 16; const f32x4 q = *(const PG8_LAS f32x4*)(X1 + rl * 4);
                const float rm = fmaxf(fmaxf(q[0], q[1]), fmaxf(q[2], q[3])); float sm = 0.f;
#pragma unroll
                for (int bj = 0; bj < 2; ++bj)
#pragma unroll
                    for (int n = 0; n < 2; ++n) { f32x4 v = acc[ai][bj][m][n];
#pragma unroll
                        for (int e = 0; e < 4; ++e) { v[e] = ex2(v[e] - rm); sm += v[e]; }
                        acc[ai][bj][m][n] = v; }
                sm += __shfl_xor(sm, 16); sm += __shfl_xor(sm, 32);
                if (fq == 0) X2[rl * 4 + wc] = sm;
            }
        asm volatile("s_waitcnt lgkmcnt(0)" ::: "memory"); __builtin_amdgcn_s_barrier(); asm volatile("" ::: "memory");
        const int col0 = u.pn * 256 + wc * 32 + 8 * fq;
#pragma unroll
        for (int ai = 0; ai < 2; ++ai)
#pragma unroll
            for (int m = 0; m < 4; ++m) {
                const int rl = rl0 + ai * 128 + m * 16; const f32x4 q = *(const PG8_LAS f32x4*)(X2 + rl * 4);
                const float inv = __builtin_amdgcn_rcpf((q[0] + q[1]) + (q[2] + q[3]));
                bf16_t* rowp = P + (size_t)(u.pm * 256 + rl) * D + col0;
#pragma unroll
                for (int bj = 0; bj < 2; ++bj) { const f32x4 v0 = acc[ai][bj][m][0] * inv, v1 = acc[ai][bj][m][1] * inv;
                    u32x4 w; w.x = pk2(v0[0], v0[1]); w.y = pk2(v0[2], v0[3]); w.z = pk2(v1[0], v1[1]); w.w = pk2(v1[2], v1[3]); *(u32x4*)(rowp + bj * 128) = w; }
            }
    }
};

constexpr int QL_STRIDE = 528;
struct EpiScaleLds {
    static constexpr bool PERM = false, AFTER_DRAIN = true;
    const float* slots; float cscale;
    __device__ __forceinline__ void fused(f32x4 (&acc)[2][2][4][2], const pg8::Unit& u, int wr, int wc, int fr, int fq, PG8_LAS unsigned char* lds, int, int) const {
        const int rl0 = wr * 64 + fr, cl0 = wc * 32 + 4 * fq;
#pragma unroll
        for (int ai = 0; ai < 2; ++ai) {
            f32x4 sv[4][4];
#pragma unroll
            for (int m = 0; m < 4; ++m) { const f32x4* sp = (const f32x4*)(slots + (size_t)(u.pm * 256 + rl0 + ai * 128 + m * 16) * 16);
#pragma unroll
                for (int q = 0; q < 4; ++q) sv[m][q] = sp[q]; }
#pragma unroll
            for (int m = 0; m < 4; ++m) { const f32x4 a = sv[m][0], b = sv[m][1], c = sv[m][2], d = sv[m][3];
                const float ss = ((a[0] + a[1]) + (a[2] + a[3])) + ((b[0] + b[1]) + (b[2] + b[3])) + ((c[0] + c[1]) + (c[2] + c[3])) + ((d[0] + d[1]) + (d[2] + d[3]));
                const float rs = rsqrtf(ss * (1.f / 1024.f) + EPS) * cscale;
                PG8_LAS unsigned char* rowp = lds + (rl0 + ai * 128 + m * 16) * QL_STRIDE + cl0 * 2;
#pragma unroll
                for (int bj = 0; bj < 2; ++bj)
#pragma unroll
                    for (int n = 0; n < 2; ++n) { const f32x4 v = acc[ai][bj][m][n] * rs; u32x2 w; w.x = pk2(v[0], v[1]); w.y = pk2(v[2], v[3]);
                        *(PG8_LAS u32x2*)(rowp + (bj * 128 + n * 16) * 2) = w; }
            }
        }
    }
};

struct EpiRes {
    static constexpr bool PERM = true, AFTER_DRAIN = false;
    const float* base32; bf16_t* h16; float* slots;
    __device__ __forceinline__ void operator()(const f32x4 (&acc)[2][2][4][2], const pg8::Unit& u, int wr, int wc, int fr, int fq) const {
        const int row0 = u.pm * 256 + wr * 64 + fr, col0 = u.pn * 256 + wc * 32 + 8 * fq;
#pragma unroll
        for (int ai = 0; ai < 2; ++ai) {
            u32x4 bw[4][2];
#pragma unroll
            for (int m = 0; m < 4; ++m)
#pragma unroll
                for (int bj = 0; bj < 2; ++bj) bw[m][bj] = *(const u32x4*)(h16 + (size_t)(row0 + ai * 128 + m * 16) * D + col0 + bj * 128);
#pragma unroll
            for (int m = 0; m < 4; ++m) {
                const int row = row0 + ai * 128 + m * 16; float ss = 0.f;
#pragma unroll
                for (int bj = 0; bj < 2; ++bj) {
                    const u32x4 w = bw[m][bj];
                    const f32x4 b0 = (f32x4){__uint_as_float(w.x << 16), __uint_as_float(w.x & 0xffff0000u), __uint_as_float(w.y << 16), __uint_as_float(w.y & 0xffff0000u)};
                    const f32x4 b1 = (f32x4){__uint_as_float(w.z << 16), __uint_as_float(w.z & 0xffff0000u), __uint_as_float(w.w << 16), __uint_as_float(w.w & 0xffff0000u)};
                    const f32x4 v0 = b0 + acc[ai][bj][m][0], v1 = b1 + acc[ai][bj][m][1];
                    ss += ((v0[0] * v0[0] + v0[1] * v0[1]) + (v0[2] * v0[2] + v0[3] * v0[3])) + ((v1[0] * v1[0] + v1[1] * v1[1]) + (v1[2] * v1[2] + v1[3] * v1[3]));
                    u32x4 o; o.x = pk2(v0[0], v0[1]); o.y = pk2(v0[2], v0[3]); o.z = pk2(v1[0], v1[1]); o.w = pk2(v1[2], v1[3]);
                    *(u32x4*)(h16 + (size_t)row * D + col0 + bj * 128) = o;
                }
                ss += __shfl_xor(ss, 16); ss += __shfl_xor(ss, 32);
                if (fq == 0) slots[(size_t)row * 16 + u.pn * 4 + wc] = ss;
            }
        }
    }
};

struct EpiResFinal {
    static constexpr bool PERM = true, AFTER_DRAIN = true;
    const bf16_t* base; float* out; const float* g; float* slots; unsigned* cnt;
    __device__ __forceinline__ void fused(f32x4 (&acc)[2][2][4][2], const pg8::Unit& u, int wr, int wc, int fr, int fq, PG8_LAS unsigned char*, int, int lane) const {
        const int row0 = u.pm * 256 + wr * 64 + fr, col0 = u.pn * 256 + wc * 32 + 8 * fq;
#pragma unroll
        for (int ai = 0; ai < 2; ++ai) {
            f32x4 bv[4][2][2];
#pragma unroll
            for (int m = 0; m < 4; ++m) { const size_t off = (size_t)(row0 + ai * 128 + m * 16) * D + col0;
#pragma unroll
                for (int bj = 0; bj < 2; ++bj) { const u32x4 w = *(const u32x4*)(base + off + bj * 128);
                    bv[m][bj][0] = (f32x4){__uint_as_float(w.x << 16), __uint_as_float(w.x & 0xffff0000u), __uint_as_float(w.y << 16), __uint_as_float(w.y & 0xffff0000u)};
                    bv[m][bj][1] = (f32x4){__uint_as_float(w.z << 16), __uint_as_float(w.z & 0xffff0000u), __uint_as_float(w.w << 16), __uint_as_float(w.w & 0xffff0000u)}; } }
            __builtin_amdgcn_sched_barrier(0);
#pragma unroll
            for (int m = 0; m < 4; ++m) {
                const int row = row0 + ai * 128 + m * 16; float ss = 0.f;
#pragma unroll
                for (int bj = 0; bj < 2; ++bj)
#pragma unroll
                    for (int n = 0; n < 2; ++n) { acc[ai][bj][m][n] += bv[m][bj][n]; const f32x4 v = acc[ai][bj][m][n]; ss += (v[0] * v[0] + v[1] * v[1]) + (v[2] * v[2] + v[3] * v[3]); }
                ss += __shfl_xor(ss, 16); ss += __shfl_xor(ss, 32);
                if (fq == 0) __hip_atomic_store(slots + (size_t)row * 16 + u.pn * 4 + wc, ss, __ATOMIC_RELAXED, __HIP_MEMORY_SCOPE_AGENT);
            }
        }
        asm volatile("s_waitcnt vmcnt(0)" ::: "memory");
        unsigned* c = cnt + 64 * u.pm;
        if (lane == 0) __hip_atomic_fetch_add(c, 1u, __ATOMIC_RELAXED, __HIP_MEMORY_SCOPE_AGENT);
        { unsigned spins = 0;
          while ((unsigned)__builtin_amdgcn_readfirstlane(__hip_atomic_load(c, __ATOMIC_RELAXED, __HIP_MEMORY_SCOPE_AGENT)) < 32u && ++spins < (1u << 18)) __builtin_amdgcn_s_sleep(2); }
        asm volatile("" ::: "memory");
        f32x4 gv[2][2];
#pragma unroll
        for (int bj = 0; bj < 2; ++bj)
#pragma unroll
            for (int n = 0; n < 2; ++n) gv[bj][n] = *(const f32x4*)(g + col0 + bj * 128 + n * 4);
#pragma unroll
        for (int ai = 0; ai < 2; ++ai)
#pragma unroll
            for (int m = 0; m < 4; ++m) {
                const int row = row0 + ai * 128 + m * 16; const float* sp = slots + (size_t)row * 16 + 4 * fq;
                float ss = (__hip_atomic_load(sp, __ATOMIC_RELAXED, __HIP_MEMORY_SCOPE_AGENT) + __hip_atomic_load(sp + 1, __ATOMIC_RELAXED, __HIP_MEMORY_SCOPE_AGENT))
                         + (__hip_atomic_load(sp + 2, __ATOMIC_RELAXED, __HIP_MEMORY_SCOPE_AGENT) + __hip_atomic_load(sp + 3, __ATOMIC_RELAXED, __HIP_MEMORY_SCOPE_AGENT));
                ss += __shfl_xor(ss, 16); ss += __shfl_xor(ss, 32);
                const float rstd = rsqrtf(ss * (1.f / 1024.f) + EPS); const size_t off = (size_t)row * D + col0;
#pragma unroll
                for (int bj = 0; bj < 2; ++bj)
#pragma unroll
                    for (int n = 0; n < 2; ++n) *(f32x4*)(out + off + bj * 128 + n * 4) = acc[ai][bj][m][n] * rstd * gv[bj][n];
            }
    }
};

DI void transpose_item(const float* W, int ldw, int K, int ncols, bf16_t* WT, LAS float* scr, int item, int lane, const float* gk) {
    const int nblk = ncols / 32, kb = item / nblk, nb = item % nblk, k0 = 64 * kb, n0 = 32 * nb;
    f32x4 tv[8];
    const float gl = gk ? gk[k0 + lane] : 1.f;
#pragma unroll
    for (int i = 0; i < 8; ++i) tv[i] = *(const f32x4*)(W + (size_t)(k0 + 8 * i + (lane >> 3)) * ldw + n0 + 4 * (lane & 7));
#pragma unroll
    for (int i = 0; i < 8; ++i) { const int kk = 8 * i + (lane >> 3); const float gg = __shfl(gl, kk);
        LAS float* d = scr + kk * 33 + 4 * (lane & 7);
        d[0] = tv[i][0] * gg; d[1] = tv[i][1] * gg; d[2] = tv[i][2] * gg; d[3] = tv[i][3] * gg; }
    asm volatile("s_waitcnt lgkmcnt(0)" ::: "memory");
    const int c = lane & 7;
#pragma unroll
    for (int j = 0; j < 4; ++j) { const int n = (lane >> 3) + 8 * j; const LAS float* s = scr + (8 * c) * 33 + n;
        u32x4 o; o.x = pk2(s[0 * 33], s[1 * 33]); o.y = pk2(s[2 * 33], s[3 * 33]); o.z = pk2(s[4 * 33], s[5 * 33]); o.w = pk2(s[6 * 33], s[7 * 33]);
        *(u32x4*)(WT + (size_t)(n0 + n) * K + k0 + 8 * c) = o; }
    asm volatile("s_waitcnt lgkmcnt(0)" ::: "memory");
}

DI void transpose_group(KP p, unsigned char* ws, LAS float* scr, int lane, int gm, int w, int nw) {
    constexpr int I_INE = 16 * 80, I_SQ = 16 * 32, I_INO = 16 * 96, I_KV = 16 * 64, I_UP = 16 * 128, I_DN = 64 * 32;
    const int c0 = (gm & 1) ? 1 : 0, c1 = (gm & 2) ? 1 : 0, c2 = (gm & 4) ? 1 : 0, q1 = (gm & 8) ? 0 : c1, q2 = (gm & 8) ? 0 : c2;
    const int nitems = c0 * (I_INE + 2 * I_KV) + c1 * (I_SQ + I_SQ + I_UP + I_DN) + q1 * I_SQ + c2 * (I_INO + I_SQ + I_SQ + I_UP + I_DN) + q2 * I_SQ;
#define TRG(s_, l_, k_, n_, d_, c_, g_) if (!found) { if (r < (c_)) { src = (s_); ldw = (l_); K = (k_); ncols = (n_); dst = (d_); gk = (g_); found = true; } else r -= (c_); }
#define TR(s_, l_, k_, n_, d_, c_) TRG(s_, l_, k_, n_, d_, c_, nullptr)
#pragma unroll 1
    for (int it = w; it < nitems; it += nw) {
        int r = it; const float* src = nullptr; const float* gk = nullptr; int ldw = 0, K = 0, ncols = 32; size_t dst = 0; bool found = false;
        TRG(p->in[7], EIN, D, EINP, W_INE, c0 * I_INE, p->in[4])
        TR(p->in[25], 2 * D, D, 2 * D, W_KV, c0 * I_KV)
        TR(p->in[25] + (size_t)D * 2 * D, 2 * D, D, 2 * D, W_KV + 4 * MiB, c0 * I_KV)
        TR(p->in[16], D, D, D, W_OUTE, c1 * I_SQ)
        TRG(p->in[24], D, D, D, W_Q, q1 * I_SQ, p->in[5])
        TR(p->in[26], D, D, D, W_O, c1 * I_SQ)
        TRG(p->in[27], FF, D, FF, W_UP, c1 * I_UP, p->in[6])
        TR(p->in[28], D, FF, D, W_DN, c1 * I_DN)
        TRG(p->in[17], OIN, D, OIN, W_INO, c2 * I_INO, p->in[4] + D)
        TR(p->in[23], D, D, D, W_OUTO, c2 * I_SQ)
        TRG(p->in[24] + (size_t)D * D, D, D, D, W_Q + 2 * MiB, q2 * I_SQ, p->in[5] + D)
        TR(p->in[26] + (size_t)D * D, D, D, D, W_O + 2 * MiB, c2 * I_SQ)
        TRG(p->in[27] + (size_t)D * FF, FF, D, FF, W_UP + 8 * MiB, c2 * I_UP, p->in[6] + D)
        TR(p->in[28] + (size_t)FF * D, D, FF, D, W_DN + 8 * MiB, c2 * I_DN)
        transpose_item(src, ldw, K, ncols, (bf16_t*)(ws + dst), scr, r, lane, gk);
    }
#undef TR
#undef TRG
}

DI void phase_prologue(KP p, LAS unsigned char* lds, int tid, int lane, int wave, int gw, int NGW, int G) {
    unsigned char* ws = p->ws;
    LAS float* scr = (LAS float*)(lds + wave * 8704);
    transpose_group(p, ws, scr, lane, (G == 256) ? 1 : 7, gw, NGW);
    for (int e = gw * 64 + lane; e < 2 * 32768; e += NGW * 64) {
        const int gate = e >> 15, r = e & 32767, g = r >> 12, j = (r >> 6) & 63, i = r & 63;
        const float* src = gate ? p->in[12] : p->in[10];
        ((bf16_t*)(ws + W_GATE))[e] = (bf16_t)(pk2(src[(g * 64 + i) * 64 + j], 0.f) & 0xffffu);
    }
    if (gw == 0) { for (int c = lane; c < 512; c += 64) ((float*)(ws + A_LSL))[c] = 8.0f * LOG2E * log_sigmoid(p->in[14][c]); }
    for (int m = gw; m < MMEM; m += NGW) {
        const f32x4* xr = (const f32x4*)(p->in[1] + (size_t)m * D) + lane; const f32x4* gr = (const f32x4*)p->in[2] + lane;
        f32x4 v[4]; float s = 0.f;
#pragma unroll
        for (int j = 0; j < 4; ++j) { v[j] = xr[64 * j]; s += (v[j][0] * v[j][0] + v[j][1] * v[j][1]) + (v[j][2] * v[j][2] + v[j][3] * v[j][3]); }
        const float rstd = rsqrtf(wave_sum(s) * (1.f / D) + EPS);
        u32x2* o8 = (u32x2*)((bf16_t*)(ws + A_MEMN) + (size_t)m * D) + lane;
#pragma unroll
        for (int j = 0; j < 4; ++j) { const f32x4 gg = gr[64 * j]; u32x2 w; w.x = pk2(v[j][0] * rstd * gg[0], v[j][1] * rstd * gg[1]); w.y = pk2(v[j][2] * rstd * gg[2], v[j][3] * rstd * gg[3]); o8[64 * j] = w; }
    }
    {
        LAS float* wfl = (LAS float*)(lds + 73728);
        __syncthreads();
        for (int q = tid; q < 2048; q += 512) { const int k = q >> 1, hf = q & 1; const f32x4 w4 = *(const f32x4*)(p->in[7] + (size_t)k * EIN + EINP + hf * 4);
            *(LAS f32x4*)(wfl + ((((k >> 8) * 4 + (k & 3)) * 64 + ((k & 255) >> 2)) * 8 + hf * 4)) = w4; }
        __syncthreads();
        const f32x4* gr = (const f32x4*)p->in[4] + lane;
        const float fb = p->in[15][lane & 7];
        f32x4 gq[4];
#pragma unroll
        for (int j = 0; j < 4; ++j) gq[j] = gr[64 * j];
        f32x4 v[4];
#pragma unroll
        for (int j = 0; j < 4; ++j) v[j] = ((const f32x4*)(p->in[0] + (size_t)gw * D) + lane)[64 * j];
#pragma unroll 1
        for (int m = gw; m < M; m += NGW) {
            f32x4 vn[4];
            const int mn = (m + NGW < M) ? m + NGW : m;
#pragma unroll
            for (int j = 0; j < 4; ++j) { const f32x4* xp = (const f32x4*)(p->in[0] + (size_t)mn * D) + lane + 64 * j; asm volatile("global_load_dwordx4 %0, %1, off" : "=v"(vn[j]) : "v"(xp)); }
            float s = 0.f;
#pragma unroll
            for (int j = 0; j < 4; ++j) s += (v[j][0] * v[j][0] + v[j][1] * v[j][1]) + (v[j][2] * v[j][2] + v[j][3] * v[j][3]);
            const float ssq = wave_sum(s); const float rstd = rsqrtf(ssq * (1.f / D) + EPS);
            u32x2* o8 = (u32x2*)((bf16_t*)(ws + A_HB) + (size_t)m * D) + lane;
            float fl[8];
#pragma unroll
            for (int c = 0; c < 8; ++c) fl[c] = 0.f;
#pragma unroll
            for (int j = 0; j < 4; ++j) { const f32x4 hv = v[j] * gq[j];
                u32x2 w; w.x = pk2(v[j][0], v[j][1]); w.y = pk2(v[j][2], v[j][3]); o8[64 * j] = w;
#pragma unroll
                for (int e = 0; e < 4; ++e)
                { const f32x4 w0 = *(const LAS f32x4*)(wfl + ((j * 4 + e) * 64 + lane) * 8), w1 = *(const LAS f32x4*)(wfl + ((j * 4 + e) * 64 + lane) * 8 + 4);
#pragma unroll
                    for (int c = 0; c < 4; ++c) { fl[c] += hv[e] * w0[c]; fl[4 + c] += hv[e] * w1[c]; } } }
            float mine = 0.f;
#pragma unroll
            for (int c = 0; c < 8; ++c) { const float t = wave_sum(fl[c]); if ((lane & 7) == c) mine = t; }
            if (lane < 16) ((float*)(ws + A_SLOT))[(size_t)m * 16 + lane] = lane == 0 ? ssq : 0.f;
            if (lane < 8) { const int b = m >> 12, sq = m & 4095; ((float*)(ws + A_LF))[(size_t)(b * 8 + lane) * SEQ + sq] = log_sigmoid(mine * rstd + fb) * LOG2E; }
            asm volatile("s_waitcnt vmcnt(0)" : "+v"(vn[0]), "+v"(vn[1]), "+v"(vn[2]), "+v"(vn[3]));
#pragma unroll
            for (int j = 0; j < 4; ++j) v[j] = vn[j];
        }
    }
}

DI void cumsum_row(float* prow, int lane) {
    f32x4* p4 = (f32x4*)prow + lane * 16; float s = 0.f;
#pragma unroll
    for (int i = 0; i < 16; ++i) { const f32x4 t = p4[i]; s -= (t[0] + t[1]) + (t[2] + t[3]); }
    float incl = s;
#pragma unroll
    for (int o = 1; o < 64; o <<= 1) { const float n = __shfl_up(incl, o); if (lane >= o) incl += n; }
    float run = incl - s;
#pragma unroll
    for (int i = 0; i < 16; ++i) { f32x4 t = p4[i]; t[0] = run - t[0]; t[1] = t[0] - t[1]; t[2] = t[1] - t[2]; t[3] = t[2] - t[3]; run = t[3]; p4[i] = t; }
}

template <int PASS> DI void lru_tile(KP p, int tile, LAS float* scr, int lane) {
    asm volatile("" : "+v"(lane));
    unsigned char* ws = p->ws;
    const int b = tile >> 9, g = (tile >> 6) & 7, chunk = tile & 63;
    const int r = lane & 31, h = lane >> 5;
    const bf16_t* Z = (const bf16_t*)(ws + A_Z);
    const bf16_t* WrT = (const bf16_t*)(ws + W_GATE) + g * 4096; const bf16_t* WiT = WrT + 32768;
    const float* conv_w = p->in[8]; const float* conv_b = p->in[9]; const float* b_r = p->in[11]; const float* b_i = p->in[13]; const float* lam = (const float*)(ws + A_LSL);
    float* carries = (float*)(ws + A_CARRY);
    LAS float* la = scr; LAS float* lu = scr + 64 * 33; LAS float* cwl = scr + 2 * 64 * 33;
    if (PASS == 1) {
#pragma unroll
        for (int tap = 0; tap < 4; ++tap) cwl[tap * 64 + lane] = conv_w[tap * 512 + g * 64 + lane];
        cwl[256 + lane] = conv_b[g * 64 + lane];
    }
    unsigned* stash = (g < 4) ? (unsigned*)((unsigned char*)p->out + 36 * MiB) : (unsigned*)(ws + 176 * MiB);
    float hstate = 0.f, pprod = 1.f;
    const int cch = g * 64 + lane;
    if (PASS == 2) {
        const f32x2_t* cp = (const f32x2_t*)carries + (size_t)(b * 64) * 512 + cch;
#pragma unroll 1
        for (int hb = 0; hb < chunk; hb += 32) {
            unsigned long long cr[32];
#pragma unroll
            for (int q = 0; q < 32; ++q) { const f32x2_t* cq = cp + (size_t)(hb + q) * 512; asm volatile("global_load_dwordx2 %0, %1, off" : "=v"(cr[q]) : "v"(cq)); }
            asm volatile("s_waitcnt vmcnt(0)" : "+v"(cr[0]), "+v"(cr[1]), "+v"(cr[2]), "+v"(cr[3]), "+v"(cr[4]), "+v"(cr[5]), "+v"(cr[6]), "+v"(cr[7]),
                                                "+v"(cr[8]), "+v"(cr[9]), "+v"(cr[10]), "+v"(cr[11]), "+v"(cr[12]), "+v"(cr[13]), "+v"(cr[14]), "+v"(cr[15]));
            asm volatile("" : "+v"(cr[16]), "+v"(cr[17]), "+v"(cr[18]), "+v"(cr[19]), "+v"(cr[20]), "+v"(cr[21]), "+v"(cr[22]), "+v"(cr[23]),
                              "+v"(cr[24]), "+v"(cr[25]), "+v"(cr[26]), "+v"(cr[27]), "+v"(cr[28]), "+v"(cr[29]), "+v"(cr[30]), "+v"(cr[31]));
#pragma unroll
            for (int q = 0; q < 32; ++q) { const float ca = __uint_as_float((unsigned)cr[q]), cb = __uint_as_float((unsigned)(cr[q] >> 32)); if (hb + q < chunk) hstate = ca * hstate + cb; }
        }
    }
#pragma unroll 1
    for (int tb = 0; tb < 2; ++tb) {
        if (PASS == 1) {
        int zz = 0; asm volatile("" : "+v"(zz));
        conv_w += zz; conv_b += zz; b_r += zz; b_i += zz; lam += zz; WrT += zz; WiT += zz;
        const int spos = chunk * 64 + tb * 32 + r;
        const size_t grow = (size_t)b * SEQ + spos;
        float xc[32];
        unsigned long long zx[8][4];
#pragma unroll
        for (int gi = 0; gi < 8; ++gi)
#pragma unroll
            for (int tap = 0; tap < 4; ++tap) {
                const bool ok = (spos - 3 + tap) >= 0;
                const bf16_t* zp = Z + (ok ? (grow - 3 + tap) : grow) * EINP + (g * 64 + 16 * (gi >> 1) + 8 * (gi & 1) + 4 * h);
                asm volatile("global_load_dwordx2 %0, %1, off" : "=v"(zx[gi][tap]) : "v"(zp));
            }
        asm volatile("s_waitcnt vmcnt(0)" : "+v"(zx[0][0]), "+v"(zx[0][1]), "+v"(zx[0][2]), "+v"(zx[0][3]), "+v"(zx[1][0]), "+v"(zx[1][1]), "+v"(zx[1][2]), "+v"(zx[1][3]),
                                            "+v"(zx[2][0]), "+v"(zx[2][1]), "+v"(zx[2][2]), "+v"(zx[2][3]), "+v"(zx[3][0]), "+v"(zx[3][1]), "+v"(zx[3][2]), "+v"(zx[3][3]));
        asm volatile("" : "+v"(zx[4][0]), "+v"(zx[4][1]), "+v"(zx[4][2]), "+v"(zx[4][3]), "+v"(zx[5][0]), "+v"(zx[5][1]), "+v"(zx[5][2]), "+v"(zx[5][3]),
                          "+v"(zx[6][0]), "+v"(zx[6][1]), "+v"(zx[6][2]), "+v"(zx[6][3]), "+v"(zx[7][0]), "+v"(zx[7][1]), "+v"(zx[7][2]), "+v"(zx[7][3]));
#pragma unroll
        for (int gi = 0; gi < 8; ++gi) {
            const int chl0 = 16 * (gi >> 1) + 8 * (gi & 1) + 4 * h;
            f32x4 a4 = *(const LAS f32x4*)(cwl + 256 + chl0);
#pragma unroll
            for (int tap = 0; tap < 4; ++tap) {
                f32x4 cw = *(const LAS f32x4*)(cwl + tap * 64 + chl0);
                if ((spos - 3 + tap) < 0) cw = (f32x4){0.f, 0.f, 0.f, 0.f};
                const unsigned lo = (unsigned)zx[gi][tap], hi = (unsigned)(zx[gi][tap] >> 32);
                a4[0] += __uint_as_float(lo << 16) * cw[0]; a4[1] += __uint_as_float(lo & 0xffff0000u) * cw[1];
                a4[2] += __uint_as_float(hi << 16) * cw[2]; a4[3] += __uint_as_float(hi & 0xffff0000u) * cw[3];
            }
#pragma unroll
            for (int e = 0; e < 4; ++e) xc[gi * 4 + e] = a4[e];
        }
        f32x16 R[2], I[2];
#pragma unroll
        for (int mb = 0; mb < 2; ++mb) { R[mb] = (f32x16){}; I[mb] = (f32x16){}; }
#pragma unroll
        for (int ks = 0; ks < 4; ++ks) {
            u32x4 bw; bw.x = pk2(xc[ks * 8 + 0], xc[ks * 8 + 1]); bw.y = pk2(xc[ks * 8 + 2], xc[ks * 8 + 3]); bw.z = pk2(xc[ks * 8 + 4], xc[ks * 8 + 5]); bw.w = pk2(xc[ks * 8 + 6], xc[ks * 8 + 7]);
            const bf16x8 bfrag = __builtin_bit_cast(bf16x8, bw);
#pragma unroll
            for (int mb = 0; mb < 2; ++mb) {
                const bf16_t* wr_ = WrT + (mb * 32 + r) * 64 + 16 * ks + 4 * h; const bf16_t* wi_ = WiT + (mb * 32 + r) * 64 + 16 * ks + 4 * h;
                const u32x2 r0 = *(const u32x2*)wr_, r1 = *(const u32x2*)(wr_ + 8), i0 = *(const u32x2*)wi_, i1 = *(const u32x2*)(wi_ + 8);
                const bf16x8 ar = __builtin_bit_cast(bf16x8, (u32x4){r0.x, r0.y, r1.x, r1.y}); const bf16x8 ai = __builtin_bit_cast(bf16x8, (u32x4){i0.x, i0.y, i1.x, i1.y});
                R[mb] = MFMA32(ar, bfrag, R[mb]); I[mb] = MFMA32(ai, bfrag, I[mb]);
            }
        }
#pragma unroll
        for (int mb = 0; mb < 2; ++mb)
#pragma unroll
            for (int i4 = 0; i4 < 4; ++i4) {
                const int chl = 32 * mb + 8 * i4 + 4 * h, chg = g * 64 + chl;
                const f32x4 br = *(const f32x4*)(b_r + chg), bi = *(const f32x4*)(b_i + chg), lm = *(const f32x4*)(lam + chg);
#pragma unroll
                for (int e = 0; e < 4; ++e) {
                    const int i = 4 * i4 + e;
                    const float rg = fsigmoid(R[mb][i] + br[e]), ig = fsigmoid(I[mb][i] + bi[e]);
                    const float a = ex2(rg * lm[e]), u = __builtin_amdgcn_sqrtf(fmaxf(1.f - a * a, 0.f)) * (ig * xc[16 * mb + i]);
                    la[(chl + e) * 33 + r] = a; lu[(chl + e) * 33 + r] = u;
                }
            }
        }
        unsigned short gbv[32]; unsigned stw[32];
        const size_t srow0 = ((size_t)b * SEQ + chunk * 64 + tb * 32) * 256 + (cch & 255);
        if (PASS == 2) {
#pragma unroll
            for (int t = 0; t < 32; ++t) { stw[t] = stash[srow0 + (size_t)t * 256]; gbv[t] = Z[((size_t)b * SEQ + chunk * 64 + tb * 32 + t) * EINP + 512 + cch]; }
        }
#pragma unroll
        for (int t = 0; t < 32; ++t) {
            float a, u;
            if (PASS == 1) { a = la[lane * 33 + t]; u = lu[lane * 33 + t]; stash[srow0 + (size_t)t * 256] = pk2(1.f - a, u); pprod *= a; }
            else { a = 1.f - __uint_as_float(stw[t] << 16); u = __uint_as_float(stw[t] & 0xffff0000u); }
            hstate = a * hstate + u;
            if (PASS == 2) {
                const size_t row = (size_t)b * SEQ + chunk * 64 + tb * 32 + t;
                ((bf16_t*)(ws + A_Y))[row * D + cch] = (bf16_t)(pk2(hstate * gelu_tanh(bf2f(gbv[t])), 0.f) & 0xffffu);
            }
        }
    }
    if (PASS == 1) { f32x2_t c = {pprod, hstate}; *(f32x2_t*)(carries + ((size_t)(b * 64 + chunk) * 512 + cch) * 2) = c; }
}

constexpr int AT_R = 4, AT_KSLOT = 8192, AT_VOFF = AT_R * AT_KSLOT, AT_VSLOT = 16384, AT_COFF = AT_VOFF + AT_R * AT_VSLOT, AT_WSF = AT_COFF + 8 * AT_R * 256, AT_QOFF = AT_WSF + 2048;
DI float max3f(float a, float b, float c) { return __builtin_fmaxf(__builtin_fmaxf(a, b), c); }
DI void glds16(const void* gsrc, unsigned lds_dst) { unsigned keep;
    asm volatile("s_mov_b32 %0, m0\n\ts_mov_b32 m0, %2\n\ts_nop 0\n\tglobal_load_lds_dwordx4 %1, off\n\ts_mov_b32 m0, %0" : "=&s"(keep) : "v"(gsrc), "s"(lds_dst) : "memory"); }
DI void glds4(const void* gsrc, unsigned lds_dst) { unsigned keep;
    asm volatile("s_mov_b32 %0, m0\n\ts_mov_b32 m0, %2\n\ts_nop 0\n\tglobal_load_lds_dword %1, off\n\ts_mov_b32 m0, %0" : "=&s"(keep) : "v"(gsrc), "s"(lds_dst) : "memory"); }
#define AT_WAIT_BAR(N) asm volatile("s_waitcnt vmcnt(" #N ") lgkmcnt(0)\n\ts_barrier" ::: "memory")
template <int DV, bool BIAS> DI void attn_pass(f32x16 (&o)[DV / 32], const bf16_t* Qb, const bf16_t* Kb, const bf16_t* Vb, int pitch, const float* cum, const float* kmaxp, int q0, LAS unsigned char* lds, int tid, int lane, int wave) {
    constexpr int VROWB = DV * 2, NDB = DV / 32, NVD = DV / 64;
#ifndef AT_QLDS128
#define AT_QLDS128 1
#endif
#ifndef AT_LMFMA128
#define AT_LMFMA128 0
#endif
    constexpr bool QLDS = (DV == 128) && AT_QLDS128, LMFMA = (DV != 128) || AT_LMFMA128;
    constexpr float THR = 8.f;
    const int r = lane & 31, h = lane >> 5, i16 = lane & 15, tq = i16 >> 2, tp = i16 & 3, blk = (lane >> 4) & 1;
    const int NT = (q0 + 256) / 64;
    const int qw0 = q0 + 32 * wave;
    const int NH = qw0 / 32 + 1;
    LAS float* wsf = (LAS float*)(lds + AT_WSF) + wave * 64;
    const unsigned lds0 = (unsigned)(uintptr_t)lds;
    bf16x8 qf[4];
    LAS unsigned char* qs = lds + AT_QOFF + wave * 4608 + r * 144 + h * 16;
#pragma unroll
    for (int ks = 0; ks < 4; ++ks) { qf[ks] = *(const bf16x8*)((Qb + (size_t)qw0 * pitch) + (unsigned)(r * pitch + 16 * ks + 8 * h)); if (QLDS) *(LAS bf16x8*)(qs + ks * 32) = qf[ks]; }
#pragma unroll
    for (int db = 0; db < NDB; ++db) o[db] = (f32x16){};
    float mhat = -INFINITY, lrun = 0.f; f32x16 lacc = (f32x16){};
    const bf16x8 ones8 = (bf16x8){0x3F80, 0x3F80, 0x3F80, 0x3F80, 0x3F80, 0x3F80, 0x3F80, 0x3F80};
    const unsigned koff_ = (unsigned)((wave * 8 + (lane >> 3)) * pitch + (((lane & 7) ^ ((lane >> 3) & 7)) * 8));
    unsigned voff_[NVD];
    if (NVD == 1) voff_[0] = koff_;
    else {
#pragma unroll
        for (int i_ = 0; i_ < NVD; ++i_) { const int row_ = (i_ * 8 + wave) * 4 + (lane >> 4); voff_[i_] = (unsigned)(row_ * pitch + (((lane & 15) ^ (row_ & 7)) * 8)); }
    }
#define AT_ISSUE(t, slot) do { const size_t tb_ = (size_t)(64 * (t)) * pitch; \
        glds16(Kb + tb_ + koff_, (unsigned)__builtin_amdgcn_readfirstlane(lds0 + (slot) * AT_KSLOT + wave * 1024)); \
        _Pragma("unroll") for (int i_ = 0; i_ < NVD; ++i_) glds16(Vb + tb_ + voff_[i_], (unsigned)__builtin_amdgcn_readfirstlane(lds0 + AT_VOFF + (slot) * AT_VSLOT + (i_ * 8 + wave) * 1024)); \
        if (BIAS) glds4(cum + 64 * (t) + lane, (unsigned)__builtin_amdgcn_readfirstlane(lds0 + AT_COFF + (wave * AT_R + (slot)) * 256)); \
        else if (NVD == 1) glds4(Kb + tb_ + koff_, (unsigned)__builtin_amdgcn_readfirstlane(lds0 + AT_COFF + (wave * AT_R + (slot)) * 256)); } while (0)
    const int kx_ = r & 7;
#define AT_QK(S, slot, half) do { const LAS unsigned char* KB_ = lds + (slot) * AT_KSLOT + (32 * (half) + r) * 128; \
        if (BIAS) { _Pragma("unroll") for (int g4 = 0; g4 < 4; ++g4) { const f32x4 c_ = *(const LAS f32x4*)(lds + AT_COFF + (wave * AT_R + (slot)) * 256 + (32 * (half) + 8 * g4 + 4 * h) * 4); \
            S[4 * g4] = c_[0]; S[4 * g4 + 1] = c_[1]; S[4 * g4 + 2] = c_[2]; S[4 * g4 + 3] = c_[3]; } } else S = (f32x16){}; \
        _Pragma("unroll") for (int ks = 0; ks < 4; ++ks) S = MFMA32(*(const LAS bf16x8*)(KB_ + (((2 * ks + h) ^ kx_) * 16)), QLDS ? *(const LAS bf16x8*)(qs + ks * 32) : qf[ks], S); } while (0)
    const int vx_ = 4 * h + tq;
#define AT_STEP(S, vslot, half, MASK) do { \
        if (MASK) { _Pragma("unroll") for (int i = 0; i < 16; ++i) if (crow(i, h) > r) S[i] = -INFINITY; } \
        float rm_ = max3f(S[0], S[1], S[2]); \
        _Pragma("unroll") for (int i = 3; i < 15; i += 2) rm_ = max3f(rm_, S[i], S[i + 1]); \
        rm_ = fmaxf(rm_, S[15]); rm_ = fmaxf(rm_, __shfl_xor(rm_, 32)); \
        if (BIAS && !__any(rm_ >= mlb)) break;     \
        if (__any(rm_ > mhat + THR)) { const float mnew_ = fmaxf(mhat, rm_); const float f_ = ex2(mhat - mnew_); mhat = mnew_; lrun *= f_; \
            if (h == 0) wsf[r] = f_; \
            _Pragma("unroll") for (int i4 = 0; i4 < 4; ++i4) { const f32x4 fv_ = *(const LAS f32x4*)(wsf + 8 * i4 + 4 * h); \
                _Pragma("unroll") for (int e = 0; e < 4; ++e) { if (LMFMA) asm volatile("v_mul_f32 %0, %0, %1" : "+v"(lacc[4 * i4 + e]) : "v"(fv_[e])); \
                    _Pragma("unroll") for (int db = 0; db < NDB; ++db) asm volatile("v_mul_f32 %0, %0, %1" : "+v"(o[db][4 * i4 + e]) : "v"(fv_[e])); } } } \
        _Pragma("unroll") for (int i = 0; i < 16; ++i) S[i] = ex2(S[i] - mhat); \
        if (!LMFMA) { float rs_ = 0.f; _Pragma("unroll") for (int i = 0; i < 16; ++i) rs_ += S[i]; lrun += rs_; } \
        if (NDB == 4) __builtin_amdgcn_sched_barrier(0); \
        _Pragma("unroll") for (int s = 0; s < 2; ++s) { u32x4 pw_; pw_.x = pk2(S[8 * s], S[8 * s + 1]); pw_.y = pk2(S[8 * s + 2], S[8 * s + 3]); pw_.z = pk2(S[8 * s + 4], S[8 * s + 5]); pw_.w = pk2(S[8 * s + 6], S[8 * s + 7]); \
            const bf16x8 pa_ = __builtin_bit_cast(bf16x8, pw_); if (LMFMA) lacc = MFMA32(pa_, ones8, lacc); \
            _Pragma("unroll") for (int db = 0; db < NDB; ++db) { const LAS unsigned char* vp_ = lds + AT_VOFF + (vslot) * AT_VSLOT + (32 * (half) + 16 * s + 4 * h + tq) * VROWB + (((db * 4 + blk * 2 + (tp >> 1)) ^ vx_) * 16) + (tp & 1) * 8; \
                const s16x4 lo_ = vtr(vp_), hi_ = vtr(vp_ + 8 * VROWB); o[db] = MFMA32(pa_, cat8(lo_, hi_), o[db]); } \
            if (NDB == 4) __builtin_amdgcn_sched_barrier(0); } } while (0)
    float mlb = -INFINITY;
    if (BIAS) {
        f32x16 Sd;
#pragma unroll
        for (int g4 = 0; g4 < 4; ++g4) { const f32x4 c_ = *(const f32x4*)(cum + qw0 + 8 * g4 + 4 * h); Sd[4 * g4] = c_[0]; Sd[4 * g4 + 1] = c_[1]; Sd[4 * g4 + 2] = c_[2]; Sd[4 * g4 + 3] = c_[3]; }
#pragma unroll
        for (int ks = 0; ks < 4; ++ks) { const bf16x8 kd = *(const bf16x8*)((Kb + (size_t)qw0 * pitch) + (unsigned)(r * pitch + 16 * ks + 8 * h)); Sd = MFMA32(kd, qf[ks], Sd); }
#pragma unroll
        for (int i = 0; i < 16; ++i) if (crow(i, h) <= r) mlb = fmaxf(mlb, Sd[i]);
        mlb = fmaxf(mlb, __shfl_xor(mlb, 32)) - 40.f;
    }
    int t0 = 0;
    if (BIAS) {
        float qn2 = 0.f;
#pragma unroll
        for (int ks = 0; ks < 4; ++ks)
#pragma unroll
            for (int e = 0; e < 8; ++e) { const float qv = bf2f((unsigned short)qf[ks][e]); qn2 += qv * qv; }
        qn2 += __shfl_xor(qn2, 32);
        float thr = mlb - __builtin_amdgcn_sqrtf(qn2 * kmaxp[0]) * 1.001f - 0.01f;
#pragma unroll
        for (int x = 1; x < 32; x <<= 1) thr = fminf(thr, __shfl_xor(thr, x));
        LAS float* wg = (LAS float*)(lds + AT_WSF);
        if (lane == 0) wsf[0] = thr;
        asm volatile("s_waitcnt lgkmcnt(0)\n\ts_barrier" ::: "memory");
        float thrw = wg[0];
#pragma unroll
        for (int w = 1; w < 8; ++w) thrw = fminf(thrw, wg[w * 64]);
        const float cend = (lane < NT) ? cum[64 * lane + 63] : INFINITY;
        const unsigned long long need = __ballot(cend >= thrw);
        t0 = need ? (int)__builtin_ctzll(need) : 0;
        if (t0 > q0 / 64) t0 = q0 / 64;
        asm volatile("s_waitcnt lgkmcnt(0)\n\ts_barrier" ::: "memory");
    }
    AT_ISSUE(t0, 0); AT_ISSUE(t0 + 1, 1); AT_ISSUE(t0 + 2, 2);
    AT_WAIT_BAR(3);
    constexpr bool PIPE = (DV != 128);
    f32x16 SA, SB;
    if (PIPE) AT_QK(SA, 0, 0);
    int sl = 0, t = t0;
    const int TA = (NH - 1) >> 1;
#define AT_PRE() const int sl1 = (sl + 1) & 3; if (t + 3 < NT) AT_ISSUE(t + 3, (sl + 3) & 3)
#define AT_POST() do { if (t + 3 < NT) AT_WAIT_BAR(3); else AT_WAIT_BAR(0); sl = sl1; } while (0)
    if (PIPE) {
#pragma unroll 1
        for (; t < TA; ++t) { AT_PRE(); AT_QK(SB, sl, 1); AT_STEP(SA, sl, 0, false); AT_QK(SA, sl1, 0); AT_STEP(SB, sl, 1, false); AT_POST(); }
        {
            AT_PRE();
            if (NH - 2 * TA == 2) { AT_QK(SB, sl, 1); AT_STEP(SA, sl, 0, false); AT_STEP(SB, sl, 1, true); }
            else { AT_STEP(SA, sl, 0, true); }
            AT_POST(); ++t;
        }
#pragma unroll 1
        for (; t < NT; ++t) { AT_PRE(); AT_POST(); }
    } else {
#pragma unroll 1
        for (; t < NT; ++t) { AT_PRE();
            if (2 * t < NH) { AT_QK(SA, sl, 0); AT_STEP(SA, sl, 0, (2 * t == NH - 1)); }
            if (2 * t + 1 < NH) { AT_QK(SA, sl, 1); AT_STEP(SA, sl, 1, (2 * t + 1 == NH - 1)); }
            AT_POST(); }
    }
#undef AT_PRE
#undef AT_POST
#undef AT_ISSUE
#undef AT_QK
#undef AT_STEP
    if (LMFMA) {
#pragma unroll
        for (int i = 0; i < 16; ++i) { const float inv = __builtin_amdgcn_rcpf(lacc[i]);
#pragma unroll
            for (int db = 0; db < NDB; ++db) o[db][i] *= inv; }
    } else {
        lrun += __shfl_xor(lrun, 32);
        if (h == 0) wsf[r] = __builtin_amdgcn_rcpf(lrun);
#pragma unroll
        for (int i4 = 0; i4 < 4; ++i4) { const f32x4 f = *(const LAS f32x4*)(wsf + 8 * i4 + 4 * h);
#pragma unroll
            for (int e = 0; e < 4; ++e)
#pragma unroll
                for (int db = 0; db < NDB; ++db) o[db][4 * i4 + e] *= f[e]; }
    }
}

constexpr int AO_KSTR = 144, AO_VOFF = 9216, AO_COFF = 9216 + 17408, AO_BUF = AO_COFF + 256, AO_WSF = 2 * AO_BUF;
template <int DV, bool BIAS> DI void attn_pass_old(f32x16 (&o)[DV / 32], const bf16_t* Qb, const bf16_t* Kb, const bf16_t* Vb, int pitch, const float* cum, int q0, LAS unsigned char* lds, int tid, int lane, int wave) {
    constexpr int VSTR = (DV + 8) * 2, NDB = DV / 32, NVL = DV / 64;
    const int r = lane & 31, h = lane >> 5, i16 = lane & 15, tq = i16 >> 2, tp = i16 & 3, blk = (lane >> 4) & 1;
    const int NT = (q0 + 256) / 64;
    const int qw0 = q0 + 32 * wave;
    LAS float* wsf = (LAS float*)(lds + AO_WSF) + wave * 64;
    bf16x8 qf[4];
#pragma unroll
    for (int ks = 0; ks < 4; ++ks) qf[ks] = *(const bf16x8*)(Qb + (size_t)(qw0 + r) * pitch + 16 * ks + 8 * h);
    float cq = 0.f; if (BIAS) cq = cum[qw0 + r];
#pragma unroll
    for (int db = 0; db < NDB; ++db) o[db] = (f32x16){};
    float mrun = -INFINITY; f32x16 lacc = (f32x16){};
    const bf16x8 ones8 = (bf16x8){0x3F80, 0x3F80, 0x3F80, 0x3F80, 0x3F80, 0x3F80, 0x3F80, 0x3F80};
    u32x4 sk, sv[NVL]; float sc = 0.f;
    const int krow_ = tid >> 3, kch = tid & 7;
#define AO_LOAD(t) do { sk = *(const u32x4*)(Kb + (size_t)(64 * (t) + krow_) * pitch + kch * 8); \
        _Pragma("unroll") for (int i_ = 0; i_ < NVL; ++i_) { const int idx_ = tid + 512 * i_; const int vr_ = (NVL == 1) ? (idx_ >> 3) : (idx_ >> 4), vc_ = (NVL == 1) ? (idx_ & 7) : (idx_ & 15); \
            sv[i_] = *(const u32x4*)(Vb + (size_t)(64 * (t) + vr_) * pitch + vc_ * 8); } \
        if (BIAS && tid < 64) sc = cum[64 * (t) + tid]; } while (0)
#define AO_STORE(buf) do { LAS unsigned char* B_ = lds + (buf) * AO_BUF; *(LAS u32x4*)(B_ + krow_ * AO_KSTR + kch * 16) = sk; \
        _Pragma("unroll") for (int i_ = 0; i_ < NVL; ++i_) { const int idx_ = tid + 512 * i_; const int vr_ = (NVL == 1) ? (idx_ >> 3) : (idx_ >> 4), vc_ = (NVL == 1) ? (idx_ & 7) : (idx_ & 15); \
            *(LAS u32x4*)(B_ + AO_VOFF + vr_ * VSTR + vc_ * 16) = sv[i_]; } \
        if (BIAS && tid < 64) *(LAS float*)(B_ + AO_COFF + tid * 4) = sc; } while (0)
    AO_LOAD(0); AO_STORE(0); __syncthreads();
#pragma unroll 1
    for (int t = 0; t < NT; ++t) {
        const int buf = t & 1;
        if (t + 1 < NT) AO_LOAD(t + 1);
        if (64 * t <= qw0 + 31) {
            const LAS unsigned char* KB = lds + buf * AO_BUF; const LAS unsigned char* VB = KB + AO_VOFF;
            f32x16 p0 = (f32x16){}, p1 = (f32x16){};
#pragma unroll
            for (int ks = 0; ks < 4; ++ks) {
                const bf16x8 k0 = *(const LAS bf16x8*)(KB + r * AO_KSTR + ks * 32 + h * 16), k1 = *(const LAS bf16x8*)(KB + (32 + r) * AO_KSTR + ks * 32 + h * 16);
                p0 = MFMA32(k0, qf[ks], p0); p1 = MFMA32(k1, qf[ks], p1);
            }
            if (BIAS) {
#pragma unroll
                for (int g4 = 0; g4 < 4; ++g4) { const f32x4 c0 = *(const LAS f32x4*)(KB + AO_COFF + (8 * g4 + 4 * h) * 4), c1 = *(const LAS f32x4*)(KB + AO_COFF + (32 + 8 * g4 + 4 * h) * 4);
#pragma unroll
                    for (int e = 0; e < 4; ++e) { p0[4 * g4 + e] += cq - c0[e]; p1[4 * g4 + e] += cq - c1[e]; } }
            }
            if (64 * t + 63 > qw0) {
                const int qpos = qw0 + r;
#pragma unroll
                for (int i = 0; i < 16; ++i) { const int kp = 64 * t + crow(i, h); if (kp > qpos) p0[i] = -INFINITY; if (kp + 32 > qpos) p1[i] = -INFINITY; }
            }
            float mx = fmaxf(p0[0], p1[0]);
#pragma unroll
            for (int i = 1; i < 16; ++i) mx = max3f(mx, p0[i], p1[i]);
            mx = fmaxf(mx, __shfl_xor(mx, 32));
            if (__any(mx > mrun + 8.f)) {
                const float mnew = fmaxf(mrun, mx); const float alpha = ex2(mrun - mnew); mrun = mnew;
                if (h == 0) wsf[r] = alpha;
#pragma unroll
                for (int i4 = 0; i4 < 4; ++i4) { const f32x4 f = *(const LAS f32x4*)(wsf + 8 * i4 + 4 * h);
#pragma unroll
                    for (int e = 0; e < 4; ++e) { lacc[4 * i4 + e] *= f[e];
#pragma unroll
                        for (int db = 0; db < NDB; ++db) o[db][4 * i4 + e] *= f[e]; } }
            }
#pragma unroll
            for (int i = 0; i < 16; ++i) { p0[i] = ex2(p0[i] - mrun); p1[i] = ex2(p1[i] - mrun); }
#pragma unroll
            for (int s = 0; s < 4; ++s) {
                const int s8 = 8 * (s & 1);
                u32x4 pw;
                if (s < 2) { pw.x = pk2(p0[s8], p0[s8 + 1]); pw.y = pk2(p0[s8 + 2], p0[s8 + 3]); pw.z = pk2(p0[s8 + 4], p0[s8 + 5]); pw.w = pk2(p0[s8 + 6], p0[s8 + 7]); }
                else       { pw.x = pk2(p1[s8], p1[s8 + 1]); pw.y = pk2(p1[s8 + 2], p1[s8 + 3]); pw.z = pk2(p1[s8 + 4], p1[s8 + 5]); pw.w = pk2(p1[s8 + 6], p1[s8 + 7]); }
                const bf16x8 pa = __builtin_bit_cast(bf16x8, pw);
                lacc = MFMA32(pa, ones8, lacc);
#pragma unroll
                for (int db = 0; db < NDB; ++db) {
                    const LAS unsigned char* vp = VB + (16 * s + 4 * h + tq) * VSTR + (db * 32 + 16 * blk + 4 * tp) * 2;
                    const s16x4 lo = vtr(vp), hi = vtr(vp + 8 * VSTR);
                    o[db] = MFMA32(pa, cat8(lo, hi), o[db]);
                }
                __builtin_amdgcn_sched_barrier(0);
            }
        }
        if (t + 1 < NT) AO_STORE(buf ^ 1);
        __syncthreads();
    }
#undef AO_LOAD
#undef AO_STORE
#pragma unroll
    for (int i = 0; i < 16; ++i) { const float inv = __builtin_amdgcn_rcpf(lacc[i]);
#pragma unroll
        for (int db = 0; db < NDB; ++db) o[db][i] *= inv; }
}

DI void fox_unit(KP p, int bh, int qb, LAS unsigned char* lds, int tid, int lane, int wave) {
    asm volatile("" : "+v"(tid), "+v"(lane));
    unsigned char* ws = p->ws; const int b = bh >> 3, hd = bh & 7, r = lane & 31, h = lane >> 5;
    const bf16_t* Zb = (const bf16_t*)(ws + A_Z) + (size_t)b * SEQ * EINP;
    f32x16 o[2];
    attn_pass<64, true>(o, Zb + 1024 + hd * 64, Zb + 1536 + hd * 64, Zb + 2048 + hd * 64, EINP, (const float*)(ws + A_LF) + (size_t)bh * SEQ, (const float*)(ws + A_KMAX) + bh, qb * 256, lds, tid, lane, wave);
    unsigned goff = 114688u + (unsigned)wave * 4608u;
    asm volatile("" : "+v"(goff));
    LAS unsigned char* stg = lds + goff;
#pragma unroll
    for (int i = 0; i < 16; ++i)
#pragma unroll
        for (int db = 0; db < 2; ++db) *(LAS bf16_t*)(stg + (crow(i, 0) + 4 * h) * 144 + (db * 32 + r) * 2) = (bf16_t)(pk2(o[db][i], 0.f) & 0xffffu);
    asm volatile("s_waitcnt lgkmcnt(0)" ::: "memory");
    bf16_t* Y = (bf16_t*)(ws + A_Y) + ((size_t)(b * SEQ + qb * 256 + 32 * wave) * D + 512 + hd * 64);
#pragma unroll
    for (int it = 0; it < 4; ++it) { const int row = it * 8 + (lane >> 3), ch = lane & 7; const u32x4 w = *(const LAS u32x4*)(stg + row * 144 + ch * 16); *(u32x4*)(Y + (size_t)row * D + ch * 8) = w; }
}
DI void diff_unit(KP p, int bh, int qb, float lam, LAS unsigned char* lds, int tid, int lane, int wave) {
    asm volatile("" : "+v"(tid), "+v"(lane));
    unsigned char* ws = p->ws; const int b = bh >> 3, hd = bh & 7, r = lane & 31, h = lane >> 5;
    const bf16_t* Zb = (const bf16_t*)(ws + A_Z) + (size_t)b * SEQ * OIN;
    unsigned soff = 69632u + (unsigned)wave * 8192u + (unsigned)lane * 4u;
    f32x16 o[4];
    attn_pass_old<128, false>(o, Zb + hd * 128, Zb + 1024 + hd * 128, Zb + 2048 + hd * 128, OIN, nullptr, qb * 256, lds, tid, lane, wave);
    asm volatile("" : "+v"(soff));
    {
        LAS unsigned* st = (LAS unsigned*)(lds + soff);
#pragma unroll
        for (int i = 0; i < 16; ++i) { st[(2 * i) * 64] = pk2(o[0][i], o[1][i]); st[(2 * i + 1) * 64] = pk2(o[2][i], o[3][i]); }
    }
    asm volatile("" : "+v"(soff) :: "memory");
    attn_pass_old<128, false>(o, Zb + hd * 128 + 64, Zb + 1024 + hd * 128 + 64, Zb + 2048 + hd * 128, OIN, nullptr, qb * 256, lds, tid, lane, wave);
    const float* ng = p->in[22];
    const float lambda_init = 0.8f - 0.6f * 0.7408182206817179f;
    float gsc[4];
#pragma unroll
    for (int db = 0; db < 4; ++db) gsc[db] = ng[db * 32 + r] * (1.f - lambda_init);
    unsigned goff = (unsigned)wave * 8704u;
    asm volatile("" : "+v"(soff), "+v"(goff));
    const LAS unsigned* st = (const LAS unsigned*)(lds + soff);
    LAS unsigned char* stg = lds + goff;
#pragma unroll
    for (int i = 0; i < 16; ++i) {
        float v[4], ss = 0.f;
        const unsigned w0 = st[(2 * i) * 64], w1 = st[(2 * i + 1) * 64];
        const float o0[4] = {__uint_as_float(w0 << 16), __uint_as_float(w0 & 0xffff0000u), __uint_as_float(w1 << 16), __uint_as_float(w1 & 0xffff0000u)};
#pragma unroll
        for (int db = 0; db < 4; ++db) { v[db] = o0[db] - lam * o[db][i]; ss += v[db] * v[db]; }
#pragma unroll
        for (int x = 1; x < 32; x <<= 1) ss += __shfl_xor(ss, x);
        const float rn = rsqrtf(ss * (1.f / 128.f) + EPS);
#pragma unroll
        for (int db = 0; db < 4; ++db) *(LAS bf16_t*)(stg + (crow(i, 0) + 4 * h) * 272 + (db * 32 + r) * 2) = (bf16_t)(pk2(v[db] * rn * gsc[db], 0.f) & 0xffffu);
        __builtin_amdgcn_sched_barrier(0);
    }
    asm volatile("s_waitcnt lgkmcnt(0)" ::: "memory");
    bf16_t* Y = (bf16_t*)(ws + A_Y) + ((size_t)(b * SEQ + qb * 256 + 32 * wave) * D + hd * 128);
#pragma unroll
    for (int it = 0; it < 8; ++it) { const int row = it * 4 + (lane >> 4), ch = lane & 15; const u32x4 w = *(const LAS u32x4*)(stg + row * 272 + ch * 16); *(u32x4*)(Y + (size_t)row * D + ch * 8) = w; }
    __syncthreads();
}

constexpr int XA_SLOT = 32768, XA_WSF = 3 * XA_SLOT;
DI void xattn_unit(const bf16_t* Q, const bf16_t* KV, bf16_t* O, int pm, int hd, LAS unsigned char* lds, int tid, int lane, int wave) {
    asm volatile("" : "+v"(tid), "+v"(lane));
    const int r = lane & 31, h = lane >> 5, i16 = lane & 15, tq = i16 >> 2, tp = i16 & 3, blk = (lane >> 4) & 1;
    const int b = pm >> 4;
    const bf16_t* Qrow = Q + (size_t)(pm * 256 + 32 * wave) * D + hd * 256;
    const bf16_t* Kb = KV + (size_t)(b * 256) * 2048 + hd * 256; const bf16_t* Vb = Kb + 1024;
    LAS float* wsf = (LAS float*)(lds + XA_WSF) + wave * 64;
    const unsigned lds0 = (unsigned)(uintptr_t)lds;
    bf16x8 qf[16];
#pragma unroll
    for (int ks = 0; ks < 16; ++ks) qf[ks] = Q ? *(const bf16x8*)(Qrow + (unsigned)(r * D + ks * 16 + 8 * h)) : *(const LAS bf16x8*)(lds + (32 * wave + r) * QL_STRIDE + (ks * 16 + 8 * h) * 2);
    if (!Q) { asm volatile("s_waitcnt lgkmcnt(0)" ::: "memory"); __syncthreads(); }
    const unsigned kofs = (unsigned)((wave * 8 + (lane >> 3)) * 2048 + (((lane & 7) ^ ((lane >> 3) & 7)) * 8));
    const unsigned vofs = (unsigned)((wave * 4 + (lane >> 4)) * 2048 + (((lane & 15) ^ (((wave & 1) * 4 + (lane >> 4)) & 7)) * 8));
#define XA_ISSUE(tl, slot) do { if ((tl) < 4) { _Pragma("unroll") for (int i_ = 0; i_ < 4; ++i_) glds16(Kb + (size_t)(i_ * 64) * 2048 + (tl) * 64 + kofs, (unsigned)__builtin_amdgcn_readfirstlane(lds0 + (slot) * XA_SLOT + (i_ * 8 + wave) * 1024)); } \
        else { const int dvh_ = ((tl) - 4) >> 1, kt_ = ((tl) - 4) & 1; _Pragma("unroll") for (int i_ = 0; i_ < 4; ++i_) glds16(Vb + (size_t)(kt_ * 128 + i_ * 32) * 2048 + dvh_ * 128 + vofs, (unsigned)__builtin_amdgcn_readfirstlane(lds0 + (slot) * XA_SLOT + (i_ * 8 + wave) * 1024)); } } while (0)
    f32x16 S[8];
#pragma unroll
    for (int kb = 0; kb < 8; ++kb) S[kb] = (f32x16){};
    asm volatile("s_waitcnt vmcnt(0)" ::: "memory");
    XA_ISSUE(0, 0); XA_ISSUE(1, 1);
    AT_WAIT_BAR(4);
    const int kx_ = r & 7, vx_ = 4 * h + tq;
#pragma unroll
    for (int kc = 0; kc < 4; ++kc) {
        const int slot = kc % 3;
        XA_ISSUE(kc + 2, (kc + 2) % 3);
#pragma unroll
        for (int ks = 0; ks < 4; ++ks) {
#pragma unroll
            for (int kb = 0; kb < 8; ++kb) { const bf16x8 kf = *(const LAS bf16x8*)(lds + slot * XA_SLOT + (kb * 32 + r) * 128 + (((2 * ks + h) ^ kx_) * 16)); S[kb] = MFMA32(kf, qf[kc * 4 + ks], S[kb]); }
            __builtin_amdgcn_sched_barrier(0);
        }
        AT_WAIT_BAR(4);
    }
    float mx = S[0][0];
#pragma unroll
    for (int kb = 0; kb < 8; ++kb)
#pragma unroll
        for (int i = 0; i < 16; ++i) mx = fmaxf(mx, S[kb][i]);
    mx = fmaxf(mx, __shfl_xor(mx, 32));
    float l = 0.f;
#pragma unroll
    for (int kb = 0; kb < 8; ++kb)
#pragma unroll
        for (int i = 0; i < 16; ++i) { S[kb][i] = ex2(S[kb][i] - mx); l += S[kb][i]; }
    l += __shfl_xor(l, 32);
    if (h == 0) wsf[r] = __builtin_amdgcn_rcpf(l);
    bf16x8 P[16];
#pragma unroll
    for (int kb = 0; kb < 8; ++kb)
#pragma unroll
        for (int s = 0; s < 2; ++s) { u32x4 pw; pw.x = pk2(S[kb][8 * s], S[kb][8 * s + 1]); pw.y = pk2(S[kb][8 * s + 2], S[kb][8 * s + 3]); pw.z = pk2(S[kb][8 * s + 4], S[kb][8 * s + 5]); pw.w = pk2(S[kb][8 * s + 6], S[kb][8 * s + 7]);
            P[2 * kb + s] = __builtin_bit_cast(bf16x8, pw); }
    unsigned ooff = (unsigned)(pm * 256 + 32 * wave + 4 * h) * D + hd * 256 + r;
#pragma unroll
    for (int dvh = 0; dvh < 2; ++dvh) {
        f32x16 o4[4];
#pragma unroll
        for (int db = 0; db < 4; ++db) o4[db] = (f32x16){};
#pragma unroll
        for (int kt = 0; kt < 2; ++kt) {
            const int tl = 4 + dvh * 2 + kt, slot = tl % 3;
            if (tl + 2 < 8) XA_ISSUE(tl + 2, (tl + 2) % 3);
#pragma unroll
            for (int s = 0; s < 8; ++s) {
#pragma unroll
                for (int db = 0; db < 4; ++db) {
                    const LAS unsigned char* vp = lds + slot * XA_SLOT + (16 * s + 4 * h + tq) * 256 + (((db * 4 + blk * 2 + (tp >> 1)) ^ vx_) * 16) + (tp & 1) * 8;
                    const s16x4 lo = vtr(vp), hi = vtr(vp + 8 * 256);
                    o4[db] = MFMA32(P[kt * 8 + s], cat8(lo, hi), o4[db]);
                }
                __builtin_amdgcn_sched_barrier(0);
            }
            if (tl + 2 < 8) AT_WAIT_BAR(4); else AT_WAIT_BAR(0);
        }
        float inv[16];
#pragma unroll
        for (int i4 = 0; i4 < 4; ++i4) { const f32x4 f = *(const LAS f32x4*)(wsf + 8 * i4 + 4 * h);
#pragma unroll
            for (int e = 0; e < 4; ++e) inv[4 * i4 + e] = f[e]; }
        asm volatile("" : "+v"(ooff));
        bf16_t* Orow = O + ooff;
#pragma unroll
        for (int i = 0; i < 16; ++i)
#pragma unroll
            for (int db = 0; db < 4; ++db) Orow[(size_t)crow(i, 0) * D + dvh * 128 + db * 32] = (bf16_t)(pk2(o4[db][i] * inv[i], 0.f) & 0xffffu);
    }
#undef XA_ISSUE
}

#define XB_TMO      128
#define XB_XCNT(j)  (256  + 64 * (j))
#define XB_XSUB(j)  (1280 + 64 * (j))
#define XB_XGEN(j)  (2304 + 64 * (j))
#define XB_TOP      3328
#define XB_TOPGEN   3392
#define XCD_BAR_WORDS 3456
#define XB_SPIN_CAP (1u << 18)

__device__ __forceinline__ unsigned xb_ld(unsigned* p)              { return __hip_atomic_load(p, __ATOMIC_RELAXED, __HIP_MEMORY_SCOPE_AGENT); }
__device__ __forceinline__ unsigned xb_add(unsigned* p, unsigned v) { return __hip_atomic_fetch_add(p, v, __ATOMIC_RELAXED, __HIP_MEMORY_SCOPE_AGENT); }
__device__ __forceinline__ unsigned xb_xcc_id() { return (unsigned)__builtin_amdgcn_s_getreg((3 << 11) | 20) & 0xFu; }
#define XB_SPIN(cond, bar) do { unsigned _sp = 0; while (cond) { __builtin_amdgcn_s_sleep(1); \
    if ((++_sp & 255u) == 0u) { if (xb_ld(&(bar)[XB_TMO])) break; if (_sp > XB_SPIN_CAP) { atomicAdd(&(bar)[XB_TMO], 1u); break; } } } } while (0)

struct XcdBarrier {
    unsigned* bar; unsigned x;
    volatile LAS unsigned* st;
};

__device__ __forceinline__ XcdBarrier xcd_barrier_post(unsigned* bar, volatile LAS unsigned* st) {
    XcdBarrier b; b.bar = bar; b.x = xb_xcc_id(); b.st = st;
    if (threadIdx.x == 0) (void)xb_add(&bar[XB_XCNT(b.x)], 1u);
    return b;
}
__device__ __forceinline__ void xcd_barrier_complete(unsigned* bar, unsigned x, unsigned& nloc, unsigned& nx) {
    const unsigned G = gridDim.x * gridDim.y * gridDim.z;
    unsigned sum, cnt, mine, sp = 0u;
    for (;;) {
        sum = 0u; cnt = 0u; mine = 0u;
#pragma unroll
        for (unsigned j = 0; j < 16; ++j) { const unsigned c = xb_ld(&bar[XB_XCNT(j)]); sum += c; cnt += (c > 0u) ? 1u : 0u; mine = (j == x) ? c : mine; }
        if (sum == G) break;
        __builtin_amdgcn_s_sleep(1);
        if ((++sp & 255u) == 0u) { if (xb_ld(&bar[XB_TMO])) break; if (sp > XB_SPIN_CAP) { atomicAdd(&bar[XB_TMO], 1u); break; } }
    }
    nloc = mine > 0u ? mine : 1u; nx = cnt > 0u ? cnt : 1u;
}

__device__ __forceinline__ void xcd_barrier(const XcdBarrier& b) {
    asm volatile("s_waitcnt vmcnt(0)" ::: "memory");
    __syncthreads();
    if (threadIdx.x == 0) {
        unsigned* bar = b.bar;
        __builtin_amdgcn_s_waitcnt(0);
        unsigned nloc = b.st[0], nx = b.st[1];
        if (nloc == 0u) { xcd_barrier_complete(bar, b.x, nloc, nx); b.st[0] = nloc; b.st[1] = nx; }
        const unsigned old = xb_add(&bar[XB_XSUB(b.x)], 1u);
        const unsigned gen = old / nloc;
        if (old + 1u == (gen + 1u) * nloc) {
            __builtin_amdgcn_fence(__ATOMIC_RELEASE, "agent");
            asm volatile("s_waitcnt vmcnt(0)" ::: "memory");
            const unsigned og = xb_add(&bar[XB_TOP], 1u);
            const unsigned tg = og / nx;
            if (og + 1u == (tg + 1u) * nx) xb_add(&bar[XB_TOPGEN], 1u);
            else XB_SPIN(xb_ld(&bar[XB_TOPGEN]) == tg, bar);
            __builtin_amdgcn_fence(__ATOMIC_ACQUIRE, "agent");
            xb_add(&bar[XB_XGEN(b.x)], 1u);
            asm volatile("s_waitcnt vmcnt(0)" ::: "memory");
        } else {
            XB_SPIN(xb_ld(&bar[XB_XGEN(b.x)]) == gen, bar);
            __builtin_amdgcn_fence(__ATOMIC_ACQUIRE, "agent");
            asm volatile("s_waitcnt vmcnt(0)" ::: "memory");
        }
    }
    __syncthreads();
}

__global__ void __launch_bounds__(512, 2) mega_fwd(Params parg) {
    extern __shared__ __attribute__((aligned(16))) unsigned char lds_raw[];
    LAS unsigned char* lds = (LAS unsigned char*)lds_raw;
    cg::grid_group grid = cg::this_grid();
    const int tid0 = threadIdx.x, wave = __builtin_amdgcn_readfirstlane(tid0 >> 6);
    const int G = gridDim.x, bx = blockIdx.x;
    const int vcu = (G % 8 == 0) ? (bx % 8) * (G / 8) + bx / 8 : bx;
    const int gw = vcu * 8 + wave, NGW = G * 8;
    const KP kp0 = (KP)__builtin_amdgcn_kernarg_segment_ptr();
    volatile LAS unsigned* barst = (volatile LAS unsigned*)(lds + LDS_BARST);
    if (tid0 < 2) barst[tid0] = 0u;
    __syncthreads();
    XcdBarrier xbar = xcd_barrier_post((unsigned*)(kp0->ws + A_BAR), barst);
    const int ph_lo = parg.ph_lo, ph_hi = parg.ph_hi;
    const float QSC64 = 0.125f * LOG2E, QSC256 = 0.0625f * LOG2E;

    for (int ph = ph_lo; ph < ph_hi; ++ph) {
        const int layer = ph >= 10 ? 1 : 0;
#pragma unroll 1
        for (int rep = 0; rep < ((ph == REPEAT_PH) ? 2 : 1); ++rep) {
        int tid = tid0; asm volatile("" : "+v"(tid));
        const int lane = tid & 63;
        KP p = kp0; asm volatile("" : "+s"(p));
        unsigned char* ws = p->ws;
        bf16_t* HB = (bf16_t*)(ws + A_HB); float* slots = (float*)(ws + A_SLOT);
        if (PH_ON(0) && ph == 0) {
            phase_prologue(p, lds, tid, lane, wave, gw, NGW, G);
        } else if (PH_ON(1) && (ph == 1 || ph == 10 || ph == 5 || ph == 13)) {
            if (ph == 1 && bx < 32 && wave == 0) cumsum_row((float*)(ws + A_LF) + (size_t)bx * SEQ, lane);
            pg8::Gemm g; EpiScale<0> E;
            if (ph == 1)       { g = pg8::Gemm{HB, (const bf16_t*)(ws + W_INE), M, EINP, D}; E = EpiScale<0>{(bf16_t*)(ws + A_Z), EINP, slots, QSC64, 4, 6}; }
            else if (ph == 10) { g = pg8::Gemm{HB, (const bf16_t*)(ws + W_INO), M, OIN, D};  E = EpiScale<0>{(bf16_t*)(ws + A_Z), OIN, slots, QSC64, 0, 4}; }
            else               { g = pg8::Gemm{HB, (const bf16_t*)(ws + W_Q + layer * 2 * MiB), M, D, D}; E = EpiScale<0>{(bf16_t*)(ws + A_XQ), D, slots, QSC256, 0, 4}; }
            pg8::StaticOrder S; S.init(g.M, g.N, G, bx);
            if ((ph == 5 || ph == 13) && G == 256) {
                pg8::Unit u; S.next(0, u);
                g.Bt = (const bf16_t*)p->out + (size_t)(layer * 4 + (u.pm >> 4)) * D * D;
                EpiSoftmaxP EP{slots, QSC256, (bf16_t*)(ws + A_XO)};
                pg8::gemm_phase<EpiSoftmaxP, pg8::StaticOrder, false, true>(lds, g, S, EP);
            } else {
            pg8::gemm_phase<EpiScale<0>, pg8::StaticOrder, true, true>(lds, g, S, E);
            if (ph == 5 || ph == 13) {
                asm volatile("s_waitcnt vmcnt(0)" ::: "memory"); __syncthreads();
                pg8::Unit u;
                for (int i = 0; S.next(i, u); ++i) xattn_unit((const bf16_t*)(ws + A_XQ), (const bf16_t*)(ws + A_KV + layer * 4 * MiB), (bf16_t*)(ws + A_XO), u.pm, u.pn, lds, tid, lane, wave);
            }
            }
            if (ph == 1 && G == 256 && bx >= 192) {
                asm volatile("s_waitcnt vmcnt(0)" ::: "memory"); __syncthreads();
                transpose_group(p, ws, (LAS float*)(lds + wave * 8704), lane, 2 + 8, (bx - 192) * 8 + wave, 512);
            }
            if (ph == 1) {
                int l0 = 0, l1 = 2, c = bx;
                if (G == 256) { const int cc = bx - 128; if (cc >= 0 && cc < 64) { l0 = cc >> 5; l1 = l0 + 1; c = cc & 31; } else l1 = 0; }
                for (int l = l0; l < l1; ++l) {
                    pg8::Gemm g2{(const bf16_t*)(ws + A_MEMN), (const bf16_t*)(ws + W_KV + l * 4 * MiB), MMEM, 2 * D, D};
                    EpiScale<0> E2{(bf16_t*)(ws + A_KV + l * 4 * MiB), 2 * D, nullptr, 1.f, 0, 0};
                    pg8::StaticOrder S2; S2.init(MMEM, 2 * D, G, c);
                    pg8::gemm_phase<EpiScale<0>, pg8::StaticOrder, true, true>(lds, g2, S2, E2);
                }
            }
        } else if (PH_ON(2) && ph == 2) {
            for (int tile = gw; tile < 2048; tile += NGW) lru_tile<1>(p, tile, (LAS float*)(lds + wave * 18176), lane);
            if (G == 256) transpose_group(p, ws, (LAS float*)(lds + wave * 18176), lane, 4 + 8, gw, NGW);
            if (G == 256) {
                bf16_t* WqN = (bf16_t*)p->out + (size_t)16 * MiB;
                for (int q4 = gw * 64 + lane; q4 < 2 * D * D / 4; q4 += NGW * 64) { const int e = q4 * 4, l = e >> 20, k = (e >> 10) & 1023;
                    const f32x4 w = *(const f32x4*)(p->in[24] + e); const float gk = p->in[5][l * D + k];
                    u32x2 o; o.x = pk2(w[0] * gk, w[1] * gk); o.y = pk2(w[2] * gk, w[3] * gk); *(u32x2*)(WqN + e) = o; }
            }
            {
                const bf16_t* Zk = (const bf16_t*)(ws + A_Z) + 1536 + lane * 8;
                if (G == 256) {
                    float mx2 = 0.f;
#pragma unroll
                    for (int k = 0; k < 8; ++k) {
                        const u32x4 kv = *(const u32x4*)(Zk + (size_t)(gw * 8 + k) * EINP); float n2 = 0.f;
#pragma unroll
                        for (int e = 0; e < 4; ++e) { const float a0 = __uint_as_float(kv[e] << 16), a1 = __uint_as_float(kv[e] & 0xffff0000u); n2 += a0 * a0 + a1 * a1; }
                        n2 += __shfl_xor(n2, 1); n2 += __shfl_xor(n2, 2); n2 += __shfl_xor(n2, 4);
                        mx2 = fmaxf(mx2, n2);
                    }
                    __syncthreads();
                    LAS float* kx = (LAS float*)lds;
                    if ((lane & 7) == 0) kx[wave * 8 + (lane >> 3)] = mx2;
                    __syncthreads();
                    if (wave == 0 && lane < 8) { float m8 = kx[lane];
#pragma unroll
                        for (int w = 1; w < 8; ++w) m8 = fmaxf(m8, kx[w * 8 + lane]);
                        atomicMax((unsigned*)(ws + A_KMAX) + ((gw * 8) >> 12) * 8 + lane, __float_as_uint(m8)); }
                } else {
                    for (int m = gw; m < M; m += NGW) {
                        const u32x4 kv = *(const u32x4*)(Zk + (size_t)m * EINP); float n2 = 0.f;
#pragma unroll
                        for (int e = 0; e < 4; ++e) { const float a0 = __uint_as_float(kv[e] << 16), a1 = __uint_as_float(kv[e] & 0xffff0000u); n2 += a0 * a0 + a1 * a1; }
                        n2 += __shfl_xor(n2, 1); n2 += __shfl_xor(n2, 2); n2 += __shfl_xor(n2, 4);
                        if ((lane & 7) == 0) atomicMax((unsigned*)(ws + A_KMAX) + (m >> 12) * 8 + (lane >> 3), __float_as_uint(n2));
                    }
                }
            }
        } else if (PH_ON(3) && ph == 3) {
            for (int r2 = 0; r2 < (REPEAT_PH == 31 ? 2 : 1); ++r2)
            for (int tile = gw; tile < 2048; tile += NGW) lru_tile<2>(p, tile, (LAS float*)(lds + wave * 18176), lane);
            __syncthreads();
            for (int r2 = 0; r2 < (REPEAT_PH == 32 ? 2 : 1); ++r2)
            for (int u = vcu; u < 256; u += G) { const int bh = u >> 3, s = u & 7; fox_unit(p, bh, 15 - s, lds, tid, lane, wave); fox_unit(p, bh, s, lds, tid, lane, wave); }
            if (G == 256) {
                __syncthreads();
                const int idx = bx >> 2, c = bx & 3, kind = idx >> 5, l = (idx >> 4) & 1, b = (idx >> 2) & 3, hh = idx & 3;
                bf16_t* OUT = (bf16_t*)p->out; const bf16_t* KVl = (const bf16_t*)(ws + A_KV + l * 4 * MiB) + (size_t)(b * 256) * 2048;
                pg8::Gemm g2; EpiScale<0> E2; pg8::StaticOrder S2;
                if (kind == 0) { g2 = pg8::Gemm{KVl + hh * 256, OUT + (size_t)16 * MiB + (size_t)l * D * D + hh * 256, 256, D, 256, 2048, D};
                    E2 = EpiScale<0>{OUT + (size_t)(l * 4 + b) * D * D + (size_t)(hh * 256) * D, D, nullptr, 1.f, 0, 0}; S2.init(256, D, 4, c); }
                else { g2 = pg8::Gemm{(const bf16_t*)(ws + W_O + l * 2 * MiB) + hh * 256, KVl + 1024 + hh * 256, D, 256, 256, D, 2048};
                    E2 = EpiScale<0>{OUT + (size_t)8 * MiB + (size_t)(l * 4 + b) * D * D + hh * 256, D, nullptr, 1.f, 0, 0}; S2.init(D, 256, 4, c); }
                pg8::gemm_phase<EpiScale<0>, pg8::StaticOrder, true, true>(lds, g2, S2, E2);
            }
        } else if (PH_ON(11) && ph == 11) {
            const float d1 = wave_sum(p->in[18][lane] * p->in[19][lane]), d2 = wave_sum(p->in[20][lane] * p->in[21][lane]);
            const float lam = __builtin_bit_cast(float, __builtin_amdgcn_readfirstlane(__builtin_bit_cast(int, __expf(d1) - __expf(d2) + (0.8f - 0.6f * 0.7408182206817179f))));
            for (int u = vcu; u < 256; u += G) { const int bh = u >> 3, s = u & 7; diff_unit(p, bh, 15 - s, lam, lds, tid, lane, wave); diff_unit(p, bh, s, lam, lds, tid, lane, wave); }
        } else if (PH_ON(4) && (ph == 4 || ph == 12 || ph == 7 || ph == 15 || ph == 9 || ph == 17)) {
            pg8::Gemm g; EpiRes E{nullptr, HB, slots};
            if (ph == 4)       g = pg8::Gemm{(const bf16_t*)(ws + A_Y), (const bf16_t*)(ws + W_OUTE), M, D, D};
            else if (ph == 12) g = pg8::Gemm{(const bf16_t*)(ws + A_Y), (const bf16_t*)(ws + W_OUTO), M, D, D};
            else if (ph == 7 || ph == 15) g = pg8::Gemm{(const bf16_t*)(ws + A_XO), (const bf16_t*)(ws + W_O + layer * 2 * MiB), M, D, D};
            else g = pg8::Gemm{(const bf16_t*)(ws + A_FF), (const bf16_t*)(ws + W_DN + layer * 8 * MiB), M, D, FF};
            pg8::StaticOrder S; S.init(g.M, g.N, G, bx);
            if ((ph == 7 || ph == 15) && G == 256) { pg8::Unit u; S.next(0, u); g.Bt = (const bf16_t*)p->out + (size_t)8 * MiB + (size_t)(layer * 4 + (u.pm >> 4)) * D * D; }
            if (ph == 17 && G == 256) {
                EpiResFinal EF{HB, p->out, p->in[3], slots, (unsigned*)(ws + A_BAR + 16384)};
                pg8::gemm_phase<EpiResFinal, pg8::StaticOrder, false, true>(lds, g, S, EF);
            } else
            pg8::gemm_phase<EpiRes, pg8::StaticOrder, true, true>(lds, g, S, E);
        } else if (ph == 6 || ph == 14) {
        } else if (false) {
            for (int u = vcu; u < 256; u += G) xattn_unit((const bf16_t*)(ws + A_XQ), (const bf16_t*)(ws + A_KV + layer * 4 * MiB), (bf16_t*)(ws + A_XO), u >> 2, u & 3, lds, tid, lane, wave);
        } else if (PH_ON(8) && (ph == 8 || ph == 16)) {
            pg8::Gemm g{HB, (const bf16_t*)(ws + W_UP + layer * 8 * MiB), M, FF, D}; EpiScale<1> E{(bf16_t*)(ws + A_FF), FF, slots, 1.f, 0, 0};
            pg8::StaticOrder S; S.init(M, FF, G, bx);
            pg8::gemm_phase<EpiScale<1>, pg8::StaticOrder, true, true>(lds, g, S, E);
        } else if (PH_ON(18) && ph == 18 && G != 256) {
            const f32x4* gr = (const f32x4*)p->in[3] + lane;
            for (int m = gw; m < M; m += NGW) {
                const f32x4* sp = (const f32x4*)(slots + (size_t)m * 16); const f32x4 a = sp[0], b = sp[1], c = sp[2], d = sp[3];
                const float ss = ((a[0] + a[1]) + (a[2] + a[3])) + ((b[0] + b[1]) + (b[2] + b[3])) + ((c[0] + c[1]) + (c[2] + c[3])) + ((d[0] + d[1]) + (d[2] + d[3]));
                const float rstd = rsqrtf(ss * (1.f / D) + EPS);
                const u32x2* hr = (const u32x2*)(HB + (size_t)m * D) + lane; f32x4* xr = (f32x4*)(p->out + (size_t)m * D) + lane;
#pragma unroll
                for (int j = 0; j < 4; ++j) { const u32x2 w = hr[64 * j]; const f32x4 v = (f32x4){__uint_as_float(w.x << 16), __uint_as_float(w.x & 0xffff0000u), __uint_as_float(w.y << 16), __uint_as_float(w.y & 0xffff0000u)};
                    xr[64 * j] = v * rstd * gr[64 * j]; }
            }
        }
        }
        if (ph + 1 < ph_hi && ph != 6 && ph != 14 && !(ph == 17 && G == 256)) { if (ph_hi > 1000) grid.sync();   else xcd_barrier(xbar); for (int xs = 0; xs < EXTRA_SYNC; ++xs) xcd_barrier(xbar); }
    }
}

extern "C" void kernel_launch(void* const* d_in, const int* in_sizes, int n_in, void* d_out, int out_size, void* d_ws, size_t ws_size, hipStream_t stream) {
    static int grid = 0;
    if (grid == 0) {
        int dev = 0, cus = 0, per_cu = 0;
        hipGetDevice(&dev);
        hipDeviceGetAttribute(&cus, hipDeviceAttributeMultiprocessorCount, dev);
        hipFuncSetAttribute((const void*)mega_fwd, hipFuncAttributeMaxDynamicSharedMemorySize, LDS_BYTES);
        hipOccupancyMaxActiveBlocksPerMultiprocessor(&per_cu, (const void*)mega_fwd, 512, LDS_BYTES);
        if (per_cu < 1) { fprintf(stderr, "kernel_launch: occupancy query says %d blocks per CU\n", per_cu); per_cu = 1; }
        if (per_cu > 1) per_cu = 1;
        grid = cus * per_cu;
        (void)hipGetLastError();
    }
    Params p{};
    for (int i = 0; i < 29; ++i) p.in[i] = (const float*)d_in[i];
    p.out = (float*)d_out; p.ws = (unsigned char*)d_ws;
#if MK_ONE_LAUNCH
    (void)hipMemsetAsync((unsigned char*)d_ws + A_BAR, 0, 32768 + 256, stream);
    p.ph_lo = 0; p.ph_hi = NPHASE;
    void* args[] = {&p};
    hipError_t e = hipLaunchCooperativeKernel((const void*)mega_fwd, dim3(grid), dim3(512), args, LDS_BYTES, stream);
    if (e != hipSuccess) fprintf(stderr, "cooperative launch failed: %s (grid %d)\n", hipGetErrorString(e), grid);
#else
    for (int ph = 0; ph < NPHASE; ++ph) { p.ph_lo = ph; p.ph_hi = ph + 1; hipLaunchKernelGGL(mega_fwd, dim3(grid), dim3(512), LDS_BYTES, stream, p); }
#endif
}
```

```cpp
#include <hip/hip_runtime.h>
#include <hip/hip_cooperative_groups.h>
#include <cstdio>
#include <cstdint>
namespace cg = cooperative_groups;
namespace pg8 {
#define PG8_LAS __attribute__((address_space(3)))
typedef unsigned short bf16_t;
typedef short bf16x8 __attribute__((ext_vector_type(8)));
typedef float f32x4 __attribute__((ext_vector_type(4)));
typedef unsigned u32x4 __attribute__((ext_vector_type(4)));
constexpr int BM = 256, BK = 64, HALF = 128, HTB = HALF * BK * 2  , STAGE_BYTES = 8 * HTB, NXCD = 8, WGM = 8;

__host__ __device__ __forceinline__ int lds_byte(int r, int c) { const int st = (r >> 4) * 2 + (c >> 5), rr = r & 15, cc = c & 31, ob = rr * 64 + cc * 2; return st * 1024 + (ob ^ (((ob >> 9) & 1) << 5)); }
__host__ __device__ __forceinline__ void stage_rc(int b, int& R, int& C) { const int st = b / 1024, sb = b % 1024, swz = sb ^ (((sb >> 9) & 1) << 5); R = (st >> 1) * 16 + swz / 64; C = (st & 1) * 32 + (swz % 64) / 2; }
__host__ __device__ __forceinline__ int perm32(int rho) { const int n = rho >> 4, i = rho & 15; return 8 * (i >> 2) + 4 * n + (i & 3); }

struct Unit { int pm, pn; };
struct Gemm { const bf16_t* A; const bf16_t* Bt; int M, N, K, lda, ldb; };

struct StaticOrder {
    int nM, nN, nwg, G, c;
    __host__ __device__ void init(int M, int N, int G_, int c_) { nM = M / BM; nN = N / BM; nwg = nM * nN; G = G_; c = c_; }
    __host__ __device__ bool next(int i, Unit& u) const {
        const long L = (long)i * G + c; if (L >= nwg) return false;
        int wgid = (int)L; { const int q = nwg / NXCD, r = nwg % NXCD, xcd = wgid % NXCD, off = wgid / NXCD; wgid = (xcd < r ? xcd * (q + 1) : r * (q + 1) + (xcd - r) * q) + off; }
        const int nig = WGM * nN, gid = wgid / nig, fm = gid * WGM, gsz = (nM - fm) < WGM ? (nM - fm) : WGM;
        u.pm = fm + ((wgid % nig) % gsz); u.pn = (wgid % nig) / gsz; return true;
    }
    __device__ __forceinline__ void a_ready(const Unit&) const {}
    __device__ __forceinline__ void done(const Unit&) const {}
};

__device__ __forceinline__ unsigned cvt_pk_bf16(float lo, float hi) { unsigned r; asm volatile("v_cvt_pk_bf16_f32 %0, %1, %2" : "=v"(r) : "v"(lo), "v"(hi)); return r; }
typedef float f32x2 __attribute__((ext_vector_type(2)));
template <class Epi, class Sched, bool ALIGN_EPI = false, bool SP2 = false>
__device__ __forceinline__ void gemm_phase(PG8_LAS unsigned char* lds, const Gemm g, const Sched& S, const Epi& E) {
    int tid_ = threadIdx.x; asm volatile("" : "+v"(tid_)); const int tid = tid_, wid = __builtin_amdgcn_readfirstlane(tid >> 6), lane = tid & 63, wr = wid >> 2, wc = wid & 3, fr = lane & 15, fq = lane >> 4;
    const int K = g.K, nt = K / BK, lda = g.lda ? g.lda : g.K, ldb = g.ldb ? g.ldb : g.K;
    unsigned voffA[2], voffB[2];
#pragma unroll
    for (int i = 0; i < 2; ++i) { int R, C; stage_rc(tid * 16 + i * 8192, R, C); const int Rb = Epi::PERM ? ((R & ~31) + perm32(R & 31)) : R;
        voffA[i] = (unsigned)(R * lda + C) * 2u; voffB[i] = (unsigned)(Rb * ldb + C) * 2u; }
    const size_t kstep = (size_t)(BK * 2);
    const size_t hstepA = (size_t)HALF * lda * 2, hstepB = (size_t)HALF * ldb * 2;
    const size_t tstepA = 2 * hstepA, tstepB = 2 * hstepB;
    const unsigned ldsw = (unsigned)wid * 1024u;
    const int aoff = lds_byte(wr * 64 + fr, fq * 8), boff = lds_byte(wc * 32 + fr, fq * 8);
#define PG8_SA(b, h) (((b) * 2 + (h)) * HTB)
#define PG8_SB(b, h) ((4 + (b) * 2 + (h)) * HTB)
#define PG8_STAGE(bufoff, gbase, voff) do { _Pragma("unroll") for (int _i = 0; _i < 2; ++_i) \
        __builtin_amdgcn_global_load_lds((const unsigned*)((const char*)(gbase) + (voff)[_i]), (PG8_LAS unsigned*)(lds + (bufoff) + ldsw + _i * 8192), 16, 0, 0); } while (0)
#define PG8_LDA(dst, b, h) do { _Pragma("unroll") for (int m = 0; m < 4; ++m) _Pragma("unroll") for (int k = 0; k < 2; ++k) dst[m][k] = *(const PG8_LAS bf16x8*)(lds + PG8_SA(b, h) + aoff + m * 2048 + k * 1024); } while (0)
#define PG8_LDB(dst, b, h) do { _Pragma("unroll") for (int n = 0; n < 2; ++n) _Pragma("unroll") for (int k = 0; k < 2; ++k) dst[n][k] = *(const PG8_LAS bf16x8*)(lds + PG8_SB(b, h) + boff + n * 2048 + k * 1024); } while (0)
#define PG8_MMA(ai, bj, At, Bt) do { __builtin_amdgcn_s_setprio(1); _Pragma("unroll") for (int m = 0; m < 4; ++m) _Pragma("unroll") for (int n = 0; n < 2; ++n) _Pragma("unroll") for (int k = 0; k < 2; ++k) \
        acc[ai][bj][m][n] = __builtin_amdgcn_mfma_f32_16x16x32_bf16(Bt[n][k], At[m][k], acc[ai][bj][m][n], 0, 0, 0); __builtin_amdgcn_s_setprio(0); } while (0)
#define PG8_WAIT_V(n) asm volatile("s_waitcnt vmcnt(" #n ")" ::: "memory")
#define PG8_WAIT_L(n) asm volatile("s_waitcnt lgkmcnt(" #n ")" ::: "memory")
#define PG8_BAR __builtin_amdgcn_s_barrier()
#define PG8_SCHED __builtin_amdgcn_sched_barrier(0)
    Unit cur, nxt; int ui = 0;
    if (!S.next(0, cur)) return;
    f32x4 acc[2][2][4][2];
#pragma unroll
    for (int a = 0; a < 2; ++a)
#pragma unroll
        for (int b = 0; b < 2; ++b)
#pragma unroll
            for (int m = 0; m < 4; ++m)
#pragma unroll
                for (int n = 0; n < 2; ++n) acc[a][b][m][n] = (f32x4){0.f, 0.f, 0.f, 0.f};
    bf16x8 At[4][2], B0[2][2], B1[2][2];
    const char* cA = (const char*)g.A + (size_t)cur.pm * tstepA; const char* cB = (const char*)g.Bt + (size_t)cur.pn * tstepB;
    S.a_ready(cur);
    if constexpr (SP2) {
        PG8_STAGE(PG8_SB(0, 0), cB, voffB); PG8_STAGE(PG8_SB(0, 1), cB + hstepB, voffB); PG8_STAGE(PG8_SA(0, 0), cA, voffA); PG8_STAGE(PG8_SA(0, 1), cA + hstepA, voffA);
        if (wr == 1) PG8_BAR;
        PG8_WAIT_V(2); PG8_BAR;
        PG8_STAGE(PG8_SB(1, 0), cB + kstep, voffB); PG8_STAGE(PG8_SA(1, 0), cA + kstep, voffA); PG8_STAGE(PG8_SB(1, 1), cB + hstepB + kstep, voffB);
        PG8_WAIT_V(6); PG8_BAR;
    } else {
        PG8_STAGE(PG8_SB(0, 0), cB, voffB); PG8_STAGE(PG8_SA(0, 0), cA, voffA); PG8_STAGE(PG8_SB(0, 1), cB + hstepB, voffB); PG8_STAGE(PG8_SA(0, 1), cA + hstepA, voffA);
        if (wr == 1) PG8_BAR;
        PG8_WAIT_V(4); PG8_BAR;
        PG8_STAGE(PG8_SB(1, 0), cB + kstep, voffB); PG8_STAGE(PG8_SA(1, 0), cA + kstep, voffA); PG8_STAGE(PG8_SB(1, 1), cB + hstepB + kstep, voffB);
        PG8_WAIT_V(6); PG8_BAR;
    }
    for (;;) {
        const bool has_next = S.next(ui + 1, nxt);
        const char* nA = has_next ? (const char*)g.A + (size_t)nxt.pm * tstepA : cA; const char* nB = has_next ? (const char*)g.Bt + (size_t)nxt.pn * tstepB : cB;
        for (int t = 0; t < nt; t += 2) {
            const bool last = (t == nt - 2);
            const char* a1 = cA + (size_t)(t + 1) * kstep;
            const char* a2 = last ? nA : cA + (size_t)(t + 2) * kstep; const char* b2 = last ? nB : cB + (size_t)(t + 2) * kstep;
            const char* a3 = a2 + kstep; const char* b3 = b2 + kstep;
            if (last && has_next) S.a_ready(nxt);
            if constexpr (SP2) {
            PG8_LDB(B0, 0, 0); PG8_LDB(B1, 0, 1); PG8_SCHED; PG8_LDA(At, 0, 0); PG8_STAGE(PG8_SA(1, 1), a1 + hstepA, voffA);
            PG8_WAIT_V(8); PG8_WAIT_L(0); PG8_BAR; PG8_MMA(0, 0, At, B0); PG8_MMA(0, 1, At, B1); PG8_BAR; PG8_SCHED;
            PG8_LDA(At, 0, 1); PG8_STAGE(PG8_SB(0, 0), b2, voffB); PG8_STAGE(PG8_SB(0, 1), b2 + hstepB, voffB); PG8_STAGE(PG8_SA(0, 0), a2, voffA);
            PG8_WAIT_V(8); PG8_WAIT_L(0); PG8_BAR; PG8_MMA(1, 0, At, B0); PG8_MMA(1, 1, At, B1); PG8_BAR; PG8_SCHED;
            PG8_LDB(B0, 1, 0); PG8_LDB(B1, 1, 1); PG8_SCHED; PG8_LDA(At, 1, 0); PG8_STAGE(PG8_SA(0, 1), a2 + hstepA, voffA);
            PG8_WAIT_V(8); PG8_WAIT_L(0); PG8_BAR; PG8_MMA(0, 0, At, B0); PG8_MMA(0, 1, At, B1); PG8_BAR; PG8_SCHED;
            PG8_LDA(At, 1, 1); PG8_STAGE(PG8_SB(1, 0), b3, voffB); PG8_STAGE(PG8_SB(1, 1), b3 + hstepB, voffB); PG8_STAGE(PG8_SA(1, 0), a3, voffA);
            PG8_WAIT_V(8); PG8_WAIT_L(0); PG8_BAR; PG8_MMA(1, 0, At, B0); PG8_MMA(1, 1, At, B1); PG8_BAR; PG8_SCHED;
            } else {
            PG8_LDB(B0, 0, 0); PG8_SCHED; PG8_LDA(At, 0, 0); PG8_STAGE(PG8_SA(1, 1), a1 + hstepA, voffA);
            PG8_WAIT_L(8); PG8_BAR; PG8_WAIT_L(0); PG8_MMA(0, 0, At, B0); PG8_BAR; PG8_SCHED;
            PG8_LDB(B1, 0, 1); PG8_STAGE(PG8_SB(0, 0), b2, voffB);
            PG8_BAR; PG8_WAIT_L(0); PG8_MMA(0, 1, At, B1); PG8_BAR;
            PG8_LDA(At, 0, 1); PG8_STAGE(PG8_SA(0, 0), a2, voffA);
            PG8_BAR; PG8_WAIT_L(0); PG8_MMA(1, 0, At, B0); PG8_BAR; PG8_SCHED;
            PG8_STAGE(PG8_SB(0, 1), b2 + hstepB, voffB);
            PG8_WAIT_V(6); PG8_BAR; PG8_MMA(1, 1, At, B1); PG8_BAR;
            PG8_LDB(B0, 1, 0); PG8_SCHED; PG8_LDA(At, 1, 0); PG8_STAGE(PG8_SA(0, 1), a2 + hstepA, voffA);
            PG8_WAIT_L(8); PG8_BAR; PG8_WAIT_L(0); PG8_MMA(0, 0, At, B0); PG8_BAR; PG8_SCHED;
            PG8_LDB(B1, 1, 1); PG8_STAGE(PG8_SB(1, 0), b3, voffB);
            PG8_BAR; PG8_WAIT_L(0); PG8_MMA(0, 1, At, B1); PG8_BAR;
            PG8_LDA(At, 1, 1); PG8_STAGE(PG8_SA(1, 0), a3, voffA);
            PG8_BAR; PG8_WAIT_L(0); PG8_MMA(1, 0, At, B0); PG8_BAR; PG8_SCHED;
            PG8_STAGE(PG8_SB(1, 1), b3 + hstepB, voffB);
            PG8_WAIT_V(6); PG8_BAR; PG8_MMA(1, 1, At, B1); PG8_BAR;
            }
        }
        if constexpr (ALIGN_EPI) { if (wr == 0) PG8_BAR; }
        if constexpr (!Epi::AFTER_DRAIN) { E(acc, cur, wr, wc, fr, fq); S.done(cur); }
        if (!has_next) break;
#pragma unroll
        for (int a = 0; a < 2; ++a)
#pragma unroll
            for (int b = 0; b < 2; ++b)
#pragma unroll
                for (int m = 0; m < 4; ++m)
#pragma unroll
                    for (int n = 0; n < 2; ++n) acc[a][b][m][n] = (f32x4){0.f, 0.f, 0.f, 0.f};
        cur = nxt; cA = nA; cB = nB; ++ui;
        if constexpr (ALIGN_EPI) { if (wr == 1) PG8_BAR; }
    }
    PG8_WAIT_V(0);
    if constexpr (!ALIGN_EPI) { if (wr == 0) PG8_BAR; }
    PG8_BAR;
    if constexpr (Epi::AFTER_DRAIN) { E.fused(acc, cur, wr, wc, fr, fq, lds, wid, lane); S.done(cur); }
#undef PG8_SA
#undef PG8_SB
#undef PG8_STAGE
#undef PG8_LDA
#undef PG8_LDB
#undef PG8_MMA
#undef PG8_WAIT_V
#undef PG8_WAIT_L
#undef PG8_BAR
#undef PG8_SCHED
}
}

using pg8::bf16_t; using pg8::bf16x8; using pg8::f32x4; using pg8::u32x4;
typedef float f32x16 __attribute__((ext_vector_type(16)));
typedef short s16x4 __attribute__((ext_vector_type(4)));
typedef unsigned u32x2 __attribute__((ext_vector_type(2)));
typedef float f32x2_t __attribute__((ext_vector_type(2)));
typedef __bf16 bf16x2_t __attribute__((ext_vector_type(2)));
#define LAS __attribute__((address_space(3)))
#define DI __device__ __forceinline__
#define MFMA32(a, b, c) __builtin_amdgcn_mfma_f32_32x32x16_bf16((a), (b), (c), 0, 0, 0)

#ifndef PHMASK
#define PHMASK 0xFFFFFFFFu
#endif
#define PH_ON(x) (((PHMASK) >> (x)) & 1u)
#ifndef REPEAT_PH
#define REPEAT_PH (-1)
#endif
#ifndef EXTRA_SYNC
#define EXTRA_SYNC 0
#endif
#ifndef USE_CG_FIRST
#define USE_CG_FIRST 1
#endif
#ifndef MK_ONE_LAUNCH
#define MK_ONE_LAUNCH 1
#endif

constexpr int D = 1024, SEQ = 4096, M = 16384, MMEM = 1024, FF = 4096;
constexpr int EIN = 2568, EINP = 2560, OIN = 3072;
constexpr float EPS = 1e-6f, LOG2E = 1.4426950408889634f;
constexpr int NPHASE = 19;
constexpr size_t MiB = 1u << 20;
constexpr size_t W_INE = 0, W_OUTE = 5 * MiB, W_INO = 7 * MiB, W_OUTO = 13 * MiB, W_Q = 15 * MiB, W_KV = 19 * MiB, W_O = 27 * MiB, W_UP = 31 * MiB, W_DN = 47 * MiB;
constexpr size_t W_GATE = 63 * MiB;
constexpr size_t A_HB = 64 * MiB;
constexpr size_t A_Z = 96 * MiB;
constexpr size_t A_XQ = 96 * MiB, A_XO = 128 * MiB;
constexpr size_t A_FF = 96 * MiB;
constexpr size_t A_Y = 192 * MiB;
constexpr size_t A_MEMN = 224 * MiB;
constexpr size_t A_KV = 226 * MiB;
constexpr size_t A_SLOT = 234 * MiB;
constexpr size_t A_LF = 235 * MiB;
constexpr size_t A_CARRY = 236 * MiB;
constexpr size_t A_KMAX = 238 * MiB + 32768;
constexpr size_t A_LSL = 237 * MiB;
constexpr size_t A_BAR = 238 * MiB;
constexpr int LDS_BYTES = 155648, LDS_BARST = 155648 - 64;

DI float bf2f(unsigned short u) { return __uint_as_float((unsigned)u << 16); }
DI unsigned pk2(float lo, float hi) { f32x2_t v = {lo, hi}; bf16x2_t b = __builtin_convertvector(v, bf16x2_t); return __builtin_bit_cast(unsigned, b); }
DI int crow(int i, int h) { return (i & 3) + 8 * (i >> 2) + 4 * h; }
DI float wave_sum(float v) {
#pragma unroll
    for (int o = 1; o < 64; o <<= 1) v += __shfl_xor(v, o);
    return v;
}
DI float ex2(float x) { return __builtin_amdgcn_exp2f(x); }
DI float fsigmoid(float x) { return __builtin_amdgcn_rcpf(1.f + ex2(-LOG2E * x)); }
DI float gelu_tanh(float x) { const float y = 0.7978845608028654f * (x + 0.044715f * x * x * x); const float e = ex2((2.f * LOG2E) * y); const float t = 1.f - 2.f * __builtin_amdgcn_rcpf(e + 1.f); return 0.5f * x * (1.f + t); }
DI float log_sigmoid(float x) { return fminf(x, 0.f) - log1pf(__expf(-fabsf(x))); }
DI s16x4 vtr(const LAS unsigned char* p) { return __builtin_bit_cast(s16x4, __builtin_amdgcn_ds_read_tr16_b64_v4i16((LAS s16x4*)p)); }
DI bf16x8 cat8(s16x4 lo, s16x4 hi) { return (bf16x8){lo[0], lo[1], lo[2], lo[3], hi[0], hi[1], hi[2], hi[3]}; }

struct Params { const float* in[29]; float* out; unsigned char* ws; int ph_lo, ph_hi; };
typedef const Params __attribute__((address_space(4)))* KP;

template <int ACT> struct EpiScale {
    static constexpr bool PERM = true, AFTER_DRAIN = false;
    bf16_t* O; int ldc; const float* slots; float cscale; int cs_lo, cs_hi;
    __device__ __forceinline__ void operator()(const f32x4 (&acc)[2][2][4][2], const pg8::Unit& u, int wr, int wc, int fr, int fq) const {
        const int row0 = u.pm * 256 + wr * 64 + fr, col0 = u.pn * 256 + wc * 32 + 8 * fq;
        const float sc = (u.pn >= cs_lo && u.pn < cs_hi) ? cscale : 1.f;
#pragma unroll
        for (int ai = 0; ai < 2; ++ai) {
            float rs[4];
            if (slots) {
                f32x4 sv[4];
#pragma unroll
                for (int m = 0; m < 4; ++m) sv[m] = *(const f32x4*)(slots + (size_t)(row0 + ai * 128 + m * 16) * 16 + 4 * fq);
                __builtin_amdgcn_sched_barrier(0);
#pragma unroll
                for (int m = 0; m < 4; ++m) { float ss = (sv[m][0] + sv[m][1]) + (sv[m][2] + sv[m][3]); ss += __shfl_xor(ss, 16); ss += __shfl_xor(ss, 32);
                    rs[m] = rsqrtf(ss * (1.f / 1024.f) + EPS); }
            } else {
#pragma unroll
                for (int m = 0; m < 4; ++m) rs[m] = 1.f;
            }
#pragma unroll
            for (int m = 0; m < 4; ++m) {
                const int row = row0 + ai * 128 + m * 16; float r_ = rs[m];
                if (ACT == 0) r_ *= sc;
                bf16_t* rowp = O + (size_t)row * ldc + col0;
#pragma unroll
                for (int bj = 0; bj < 2; ++bj) { f32x4 v0 = acc[ai][bj][m][0] * r_, v1 = acc[ai][bj][m][1] * r_;
                    if (ACT == 1) {
#pragma unroll
                        for (int e = 0; e < 4; ++e) { const float a0 = fmaxf(v0[e], 0.f), a1 = fmaxf(v1[e], 0.f); v0[e] = a0 * a0; v1[e] = a1 * a1; } }
                    u32x4 w; w.x = pk2(v0[0], v0[1]); w.y = pk2(v0[2], v0[3]); w.z = pk2(v1[0], v1[1]); w.w = pk2(v1[2], v1[3]);
                    *(u32x4*)(rowp + bj * 128) = w; }
            }
        }
    }
};
struct EpiSoftmaxP {
    static constexpr bool PERM = true, AFTER_DRAIN = true;
    const float* slots; float cscale; bf16_t* P;
    __device__ __forceinline__ void fused(f32x4 (&acc)[2][2][4][2], const pg8::Unit& u, int wr, int wc, int fr, int fq, PG8_LAS unsigned char* lds, int, int) const {
        PG8_LAS float* X1 = (PG8_LAS float*)lds; PG8_LAS float* X2 = X1 + 1024;
        const int rl0 = wr * 64 + fr;
#pragma unroll
        for (int ai = 0; ai < 2; ++ai)
#pragma unroll
            for (int m = 0; m < 4; ++m) {
                const f32x4 a = *(const f32x4*)(slots + (size_t)(u.pm * 256 + rl0 + ai * 128 + m * 16) * 16 + 4 * fq);
                float ss = (a[0] + a[1]) + (a[2] + a[3]); ss += __shfl_xor(ss, 16); ss += __shfl_xor(ss, 32);
                const float rs = rsqrtf(ss * (1.f / 1024.f) + EPS) * cscale; float mx = -INFINITY;
#pragma unroll
                for (int bj = 0; bj < 2; ++bj)
#pragma unroll
                    for (int n = 0; n < 2; ++n) { acc[ai][bj][m][n] *= rs; const f32x4 v = acc[ai][bj][m][n]; mx = fmaxf(mx, fmaxf(fmaxf(v[0], v[1]), fmaxf(v[2], v[3]))); }
                mx = fmaxf(mx, __shfl_xor(mx, 16)); mx = fmaxf(mx, __shfl_xor(mx, 32));
                if (fq == 0) X1[(rl0 + ai * 128 + m * 16) * 4 + wc] = mx;
            }
        asm volatile("s_waitcnt lgkmcnt(0)" ::: "memory"); __builtin_amdgcn_s_barrier(); asm volatile("" ::: "memory");
#pragma unroll
        for (int ai = 0; ai < 2; ++ai)
#pragma unroll
            for (int m = 0; m < 4; ++m) {
                const int rl = rl0 + ai * 128 + m * 16; const f32x4 q = *(const PG8_LAS f32x4*)(X1 + rl * 4);
                const float rm = fmaxf(fmaxf(q[0], q[1]), fmaxf(q[2], q[3])); float sm = 0.f;
#pragma unroll
                for (int bj = 0; bj < 2; ++bj)
#pragma unroll
                    for (int n = 0; n < 2; ++n) { f32x4 v = acc[ai][bj][m][n];
#pragma unroll
                        for (int e = 0; e < 4; ++e) { v[e] = ex2(v[e] - rm); sm += v[e]; }
                        acc[ai][bj][m][n] = v; }
                sm += __shfl_xor(sm, 16); sm += __shfl_xor(sm, 32);
                if (fq == 0) X2[rl * 4 + wc] = sm;
            }
        asm volatile("s_waitcnt lgkmcnt(0)" ::: "memory"); __builtin_amdgcn_s_barrier(); asm volatile("" ::: "memory");
        const int col0 = u.pn * 256 + wc * 32 + 8 * fq;
#pragma unroll
        for (int ai = 0; ai < 2; ++ai)
#pragma unroll
            for (int m = 0; m < 4; ++m) {
                const int rl = rl0 + ai * 128 + m * 16; const f32x4 q = *(const PG8_LAS f32x4*)(X2 + rl * 4);
                const float inv = __builtin_amdgcn_rcpf((q[0] + q[1]) + (q[2] + q[3]));
                bf16_t* rowp = P + (size_t)(u.pm * 256 + rl) * D + col0;
#pragma unroll
                for (int bj = 0; bj < 2; ++bj) { const f32x4 v0 = acc[ai][bj][m][0] * inv, v1 = acc[ai][bj][m][1] * inv;
                    u32x4 w; w.x = pk2(v0[0], v0[1]); w.y = pk2(v0[2], v0[3]); w.z = pk2(v1[0], v1[1]); w.w = pk2(v1[2], v1[3]); *(u32x4*)(rowp + bj * 128) = w; }
            }
    }
};

constexpr int QL_STRIDE = 528;
struct EpiScaleLds {
    static constexpr bool PERM = false, AFTER_DRAIN = true;
    const float* slots; float cscale;
    __device__ __forceinline__ void fused(f32x4 (&acc)[2][2][4][2], const pg8::Unit& u, int wr, int wc, int fr, int fq, PG8_LAS unsigned char* lds, int, int) const {
        const int rl0 = wr * 64 + fr, cl0 = wc * 32 + 4 * fq;
#pragma unroll
        for (int ai = 0; ai < 2; ++ai) {
            f32x4 sv[4][4];
#pragma unroll
            for (int m = 0; m < 4; ++m) { const f32x4* sp = (const f32x4*)(slots + (size_t)(u.pm * 256 + rl0 + ai * 128 + m * 16) * 16);
#pragma unroll
                for (int q = 0; q < 4; ++q) sv[m][q] = sp[q]; }
#pragma unroll
            for (int m = 0; m < 4; ++m) { const f32x4 a = sv[m][0], b = sv[m][1], c = sv[m][2], d = sv[m][3];
                const float ss = ((a[0] + a[1]) + (a[2] + a[3])) + ((b[0] + b[1]) + (b[2] + b[3])) + ((c[0] + c[1]) + (c[2] + c[3])) + ((d[0] + d[1]) + (d[2] + d[3]));
                const float rs = rsqrtf(ss * (1.f / 1024.f) + EPS) * cscale;
                PG8_LAS unsigned char* rowp = lds + (rl0 + ai * 128 + m * 16) * QL_STRIDE + cl0 * 2;
#pragma unroll
                for (int bj = 0; bj < 2; ++bj)
#pragma unroll
                    for (int n = 0; n < 2; ++n) { const f32x4 v = acc[ai][bj][m][n] * rs; u32x2 w; w.x = pk2(v[0], v[1]); w.y = pk2(v[2], v[3]);
                        *(PG8_LAS u32x2*)(rowp + (bj * 128 + n * 16) * 2) = w; }
            }
        }
    }
};

struct EpiRes {
    static constexpr bool PERM = true, AFTER_DRAIN = false;
    const float* base32; bf16_t* h16; float* slots;
    __device__ __forceinline__ void operator()(const f32x4 (&acc)[2][2][4][2], const pg8::Unit& u, int wr, int wc, int fr, int fq) const {
        const int row0 = u.pm * 256 + wr * 64 + fr, col0 = u.pn * 256 + wc * 32 + 8 * fq;
#pragma unroll
        for (int ai = 0; ai < 2; ++ai) {
            u32x4 bw[4][2];
#pragma unroll
            for (int m = 0; m < 4; ++m)
#pragma unroll
                for (int bj = 0; bj < 2; ++bj) bw[m][bj] = *(const u32x4*)(h16 + (size_t)(row0 + ai * 128 + m * 16) * D + col0 + bj * 128);
#pragma unroll
            for (int m = 0; m < 4; ++m) {
                const int row = row0 + ai * 128 + m * 16; float ss = 0.f;
#pragma unroll
                for (int bj = 0; bj < 2; ++bj) {
                    const u32x4 w = bw[m][bj];
                    const f32x4 b0 = (f32x4){__uint_as_float(w.x << 16), __uint_as_float(w.x & 0xffff0000u), __uint_as_float(w.y << 16), __uint_as_float(w.y & 0xffff0000u)};
                    const f32x4 b1 = (f32x4){__uint_as_float(w.z << 16), __uint_as_float(w.z & 0xffff0000u), __uint_as_float(w.w << 16), __uint_as_float(w.w & 0xffff0000u)};
                    const f32x4 v0 = b0 + acc[ai][bj][m][0], v1 = b1 + acc[ai][bj][m][1];
                    ss += ((v0[0] * v0[0] + v0[1] * v0[1]) + (v0[2] * v0[2] + v0[3] * v0[3])) + ((v1[0] * v1[0] + v1[1] * v1[1]) + (v1[2] * v1[2] + v1[3] * v1[3]));
                    u32x4 o; o.x = pk2(v0[0], v0[1]); o.y = pk2(v0[2], v0[3]); o.z = pk2(v1[0], v1[1]); o.w = pk2(v1[2], v1[3]);
                    *(u32x4*)(h16 + (size_t)row * D + col0 + bj * 128) = o;
                }
                ss += __shfl_xor(ss, 16); ss += __shfl_xor(ss, 32);
                if (fq == 0) slots[(size_t)row * 16 + u.pn * 4 + wc] = ss;
            }
        }
    }
};

struct EpiResFinal {
    static constexpr bool PERM = true, AFTER_DRAIN = true;
    const bf16_t* base; float* out; const float* g; float* slots; unsigned* cnt;
    __device__ __forceinline__ void fused(f32x4 (&acc)[2][2][4][2], const pg8::Unit& u, int wr, int wc, int fr, int fq, PG8_LAS unsigned char*, int, int lane) const {
        const int row0 = u.pm * 256 + wr * 64 + fr, col0 = u.pn * 256 + wc * 32 + 8 * fq;
#pragma unroll
        for (int ai = 0; ai < 2; ++ai) {
            f32x4 bv[4][2][2];
#pragma unroll
            for (int m = 0; m < 4; ++m) { const size_t off = (size_t)(row0 + ai * 128 + m * 16) * D + col0;
#pragma unroll
                for (int bj = 0; bj < 2; ++bj) { const u32x4 w = *(const u32x4*)(base + off + bj * 128);
                    bv[m][bj][0] = (f32x4){__uint_as_float(w.x << 16), __uint_as_float(w.x & 0xffff0000u), __uint_as_float(w.y << 16), __uint_as_float(w.y & 0xffff0000u)};
                    bv[m][bj][1] = (f32x4){__uint_as_float(w.z << 16), __uint_as_float(w.z & 0xffff0000u), __uint_as_float(w.w << 16), __uint_as_float(w.w & 0xffff0000u)}; } }
            __builtin_amdgcn_sched_barrier(0);
#pragma unroll
            for (int m = 0; m < 4; ++m) {
                const int row = row0 + ai * 128 + m * 16; float ss = 0.f;
#pragma unroll
                for (int bj = 0; bj < 2; ++bj)
#pragma unroll
                    for (int n = 0; n < 2; ++n) { acc[ai][bj][m][n] += bv[m][bj][n]; const f32x4 v = acc[ai][bj][m][n]; ss += (v[0] * v[0] + v[1] * v[1]) + (v[2] * v[2] + v[3] * v[3]); }
                ss += __shfl_xor(ss, 16); ss += __shfl_xor(ss, 32);
                if (fq == 0) __hip_atomic_store(slots + (size_t)row * 16 + u.pn * 4 + wc, ss, __ATOMIC_RELAXED, __HIP_MEMORY_SCOPE_AGENT);
            }
        }
        asm volatile("s_waitcnt vmcnt(0)" ::: "memory");
        unsigned* c = cnt + 64 * u.pm;
        if (lane == 0) __hip_atomic_fetch_add(c, 1u, __ATOMIC_RELAXED, __HIP_MEMORY_SCOPE_AGENT);
        { unsigned spins = 0;
          while ((unsigned)__builtin_amdgcn_readfirstlane(__hip_atomic_load(c, __ATOMIC_RELAXED, __HIP_MEMORY_SCOPE_AGENT)) < 32u && ++spins < (1u << 18)) __builtin_amdgcn_s_sleep(2); }
        asm volatile("" ::: "memory");
        f32x4 gv[2][2];
#pragma unroll
        for (int bj = 0; bj < 2; ++bj)
#pragma unroll
            for (int n = 0; n < 2; ++n) gv[bj][n] = *(const f32x4*)(g + col0 + bj * 128 + n * 4);
#pragma unroll
        for (int ai = 0; ai < 2; ++ai)
#pragma unroll
            for (int m = 0; m < 4; ++m) {
                const int row = row0 + ai * 128 + m * 16; const float* sp = slots + (size_t)row * 16 + 4 * fq;
                float ss = (__hip_atomic_load(sp, __ATOMIC_RELAXED, __HIP_MEMORY_SCOPE_AGENT) + __hip_atomic_load(sp + 1, __ATOMIC_RELAXED, __HIP_MEMORY_SCOPE_AGENT))
                         + (__hip_atomic_load(sp + 2, __ATOMIC_RELAXED, __HIP_MEMORY_SCOPE_AGENT) + __hip_atomic_load(sp + 3, __ATOMIC_RELAXED, __HIP_MEMORY_SCOPE_AGENT));
                ss += __shfl_xor(ss, 16); ss += __shfl_xor(ss, 32);
                const float rstd = rsqrtf(ss * (1.f / 1024.f) + EPS); const size_t off = (size_t)row * D + col0;
#pragma unroll
                for (int bj = 0; bj < 2; ++bj)
#pragma unroll
                    for (int n = 0; n < 2; ++n) *(f32x4*)(out + off + bj * 128 + n * 4) = acc[ai][bj][m][n] * rstd * gv[bj][n];
            }
    }
};

DI void transpose_item(const float* W, int ldw, int K, int ncols, bf16_t* WT, LAS float* scr, int item, int lane, const float* gk) {
    const int nblk = ncols / 32, kb = item / nblk, nb = item % nblk, k0 = 64 * kb, n0 = 32 * nb;
    float tv[32];
    const float gl = gk ? gk[k0 + lane] : 1.f;
#pragma unroll
    for (int i = 0; i < 32; ++i) tv[i] = W[(size_t)(k0 + 2 * i + (lane >> 5)) * ldw + n0 + (lane & 31)];
#pragma unroll
    for (int i = 0; i < 32; ++i) { const float g0 = __builtin_bit_cast(float, __builtin_amdgcn_readlane(__builtin_bit_cast(int, gl), 2 * i)), g1 = __builtin_bit_cast(float, __builtin_amdgcn_readlane(__builtin_bit_cast(int, gl), 2 * i + 1));
        scr[(2 * i + (lane >> 5)) * 33 + (lane & 31)] = tv[i] * ((lane >> 5) ? g1 : g0); }
    asm volatile("s_waitcnt lgkmcnt(0)" ::: "memory");
    const int c = lane & 7;
#pragma unroll
    for (int j = 0; j < 4; ++j) { const int n = (lane >> 3) + 8 * j; const LAS float* s = scr + (8 * c) * 33 + n;
        u32x4 o; o.x = pk2(s[0 * 33], s[1 * 33]); o.y = pk2(s[2 * 33], s[3 * 33]); o.z = pk2(s[4 * 33], s[5 * 33]); o.w = pk2(s[6 * 33], s[7 * 33]);
        *(u32x4*)(WT + (size_t)(n0 + n) * K + k0 + 8 * c) = o; }
    asm volatile("s_waitcnt lgkmcnt(0)" ::: "memory");
}

DI void transpose_group(KP p, unsigned char* ws, LAS float* scr, int lane, int gm, int w, int nw) {
    constexpr int I_INE = 16 * 80, I_SQ = 16 * 32, I_INO = 16 * 96, I_KV = 16 * 64, I_UP = 16 * 128, I_DN = 64 * 32;
    const int c0 = (gm & 1) ? 1 : 0, c1 = (gm & 2) ? 1 : 0, c2 = (gm & 4) ? 1 : 0, q1 = (gm & 8) ? 0 : c1, q2 = (gm & 8) ? 0 : c2;
    const int nitems = c0 * (I_INE + 2 * I_KV) + c1 * (I_SQ + I_SQ + I_UP + I_DN) + q1 * I_SQ + c2 * (I_INO + I_SQ + I_SQ + I_UP + I_DN) + q2 * I_SQ;
#define TRG(s_, l_, k_, n_, d_, c_, g_) if (!found) { if (r < (c_)) { src = (s_); ldw = (l_); K = (k_); ncols = (n_); dst = (d_); gk = (g_); found = true; } else r -= (c_); }
#define TR(s_, l_, k_, n_, d_, c_) TRG(s_, l_, k_, n_, d_, c_, nullptr)
#pragma unroll 1
    for (int it = w; it < nitems; it += nw) {
        int r = it; const float* src = nullptr; const float* gk = nullptr; int ldw = 0, K = 0, ncols = 32; size_t dst = 0; bool found = false;
        TRG(p->in[7], EIN, D, EINP, W_INE, c0 * I_INE, p->in[4])
        TR(p->in[25], 2 * D, D, 2 * D, W_KV, c0 * I_KV)
        TR(p->in[25] + (size_t)D * 2 * D, 2 * D, D, 2 * D, W_KV + 4 * MiB, c0 * I_KV)
        TR(p->in[16], D, D, D, W_OUTE, c1 * I_SQ)
        TRG(p->in[24], D, D, D, W_Q, q1 * I_SQ, p->in[5])
        TR(p->in[26], D, D, D, W_O, c1 * I_SQ)
        TRG(p->in[27], FF, D, FF, W_UP, c1 * I_UP, p->in[6])
        TR(p->in[28], D, FF, D, W_DN, c1 * I_DN)
        TRG(p->in[17], OIN, D, OIN, W_INO, c2 * I_INO, p->in[4] + D)
        TR(p->in[23], D, D, D, W_OUTO, c2 * I_SQ)
        TRG(p->in[24] + (size_t)D * D, D, D, D, W_Q + 2 * MiB, q2 * I_SQ, p->in[5] + D)
        TR(p->in[26] + (size_t)D * D, D, D, D, W_O + 2 * MiB, c2 * I_SQ)
        TRG(p->in[27] + (size_t)D * FF, FF, D, FF, W_UP + 8 * MiB, c2 * I_UP, p->in[6] + D)
        TR(p->in[28] + (size_t)FF * D, D, FF, D, W_DN + 8 * MiB, c2 * I_DN)
        transpose_item(src, ldw, K, ncols, (bf16_t*)(ws + dst), scr, r, lane, gk);
    }
#undef TR
#undef TRG
}

DI void phase_prologue(KP p, LAS unsigned char* lds, int tid, int lane, int wave, int gw, int NGW, int G) {
    unsigned char* ws = p->ws;
    LAS float* scr = (LAS float*)(lds + wave * 8704);
    transpose_group(p, ws, scr, lane, (G == 256) ? 1 : 7, gw, NGW);
    for (int e = gw * 64 + lane; e < 2 * 32768; e += NGW * 64) {
        const int gate = e >> 15, r = e & 32767, g = r >> 12, j = (r >> 6) & 63, i = r & 63;
        const float* src = gate ? p->in[12] : p->in[10];
        ((bf16_t*)(ws + W_GATE))[e] = (bf16_t)(pk2(src[(g * 64 + i) * 64 + j], 0.f) & 0xffffu);
    }
    if (gw == 0) { for (int c = lane; c < 512; c += 64) ((float*)(ws + A_LSL))[c] = 8.0f * LOG2E * log_sigmoid(p->in[14][c]); }
    for (int m = gw; m < MMEM; m += NGW) {
        const f32x4* xr = (const f32x4*)(p->in[1] + (size_t)m * D) + lane; const f32x4* gr = (const f32x4*)p->in[2] + lane;
        f32x4 v[4], gm4[4]; float s = 0.f;
#pragma unroll
        for (int j = 0; j < 4; ++j) gm4[j] = gr[64 * j];
#pragma unroll
        for (int j = 0; j < 4; ++j) { v[j] = xr[64 * j]; s += (v[j][0] * v[j][0] + v[j][1] * v[j][1]) + (v[j][2] * v[j][2] + v[j][3] * v[j][3]); }
        const float rstd = rsqrtf(wave_sum(s) * (1.f / D) + EPS);
        u32x2* o8 = (u32x2*)((bf16_t*)(ws + A_MEMN) + (size_t)m * D) + lane;
#pragma unroll
        for (int j = 0; j < 4; ++j) { const f32x4 gg = gm4[j]; u32x2 w; w.x = pk2(v[j][0] * rstd * gg[0], v[j][1] * rstd * gg[1]); w.y = pk2(v[j][2] * rstd * gg[2], v[j][3] * rstd * gg[3]); o8[64 * j] = w; }
    }
    {
        LAS float* wfl = (LAS float*)(lds + 73728);
        __syncthreads();
        for (int q = tid; q < 2048; q += 512) { const int k = q >> 1, hf = q & 1; const f32x4 w4 = *(const f32x4*)(p->in[7] + (size_t)k * EIN + EINP + hf * 4);
            *(LAS f32x4*)(wfl + ((((k >> 8) * 4 + (k & 3)) * 64 + ((k & 255) >> 2)) * 8 + hf * 4)) = w4; }
        __syncthreads();
        const f32x4* gr = (const f32x4*)p->in[4] + lane;
        const float fb = p->in[15][lane & 7];
        f32x4 gq[4];
#pragma unroll
        for (int j = 0; j < 4; ++j) gq[j] = gr[64 * j];
        f32x4 v[4];
#pragma unroll
        for (int j = 0; j < 4; ++j) v[j] = ((const f32x4*)(p->in[0] + (size_t)gw * D) + lane)[64 * j];
#pragma unroll 1
        for (int m = gw; m < M; m += NGW) {
            f32x4 vn[4];
            const int mn = (m + NGW < M) ? m + NGW : m;
#pragma unroll
            for (int j = 0; j < 4; ++j) { const f32x4* xp = (const f32x4*)(p->in[0] + (size_t)mn * D) + lane + 64 * j; asm volatile("global_load_dwordx4 %0, %1, off" : "=v"(vn[j]) : "v"(xp)); }
            float s = 0.f;
#pragma unroll
            for (int j = 0; j < 4; ++j) s += (v[j][0] * v[j][0] + v[j][1] * v[j][1]) + (v[j][2] * v[j][2] + v[j][3] * v[j][3]);
            const float ssq = wave_sum(s); const float rstd = rsqrtf(ssq * (1.f / D) + EPS);
            u32x2* o8 = (u32x2*)((bf16_t*)(ws + A_HB) + (size_t)m * D) + lane;
            float fl[8];
#pragma unroll
            for (int c = 0; c < 8; ++c) fl[c] = 0.f;
#pragma unroll
            for (int j = 0; j < 4; ++j) { const f32x4 hv = v[j] * gq[j];
                u32x2 w; w.x = pk2(v[j][0], v[j][1]); w.y = pk2(v[j][2], v[j][3]); o8[64 * j] = w;
#pragma unroll
                for (int e = 0; e < 4; ++e)
                { const f32x4 w0 = *(const LAS f32x4*)(wfl + ((j * 4 + e) * 64 + lane) * 8), w1 = *(const LAS f32x4*)(wfl + ((j * 4 + e) * 64 + lane) * 8 + 4);
#pragma unroll
                    for (int c = 0; c < 4; ++c) { fl[c] += hv[e] * w0[c]; fl[4 + c] += hv[e] * w1[c]; } } }
            float mine = 0.f;
#pragma unroll
            for (int c = 0; c < 8; ++c) { const float t = wave_sum(fl[c]); if ((lane & 7) == c) mine = t; }
            if (lane < 16) ((float*)(ws + A_SLOT))[(size_t)m * 16 + lane] = lane == 0 ? ssq : 0.f;
            if (lane < 8) { const int b = m >> 12, sq = m & 4095; ((float*)(ws + A_LF))[(size_t)(b * 8 + lane) * SEQ + sq] = log_sigmoid(mine * rstd + fb) * LOG2E; }
            asm volatile("s_waitcnt vmcnt(0)" : "+v"(vn[0]), "+v"(vn[1]), "+v"(vn[2]), "+v"(vn[3]));
#pragma unroll
            for (int j = 0; j < 4; ++j) v[j] = vn[j];
        }
    }
}

DI void cumsum_row(float* prow, int lane) {
    f32x4* p4 = (f32x4*)prow + lane * 16; float s = 0.f;
#pragma unroll
    for (int i = 0; i < 16; ++i) { const f32x4 t = p4[i]; s -= (t[0] + t[1]) + (t[2] + t[3]); }
    float incl = s;
#pragma unroll
    for (int o = 1; o < 64; o <<= 1) { const float n = __shfl_up(incl, o); if (lane >= o) incl += n; }
    float run = incl - s;
#pragma unroll
    for (int i = 0; i < 16; ++i) { f32x4 t = p4[i]; t[0] = run - t[0]; t[1] = t[0] - t[1]; t[2] = t[1] - t[2]; t[3] = t[2] - t[3]; run = t[3]; p4[i] = t; }
}

template <int PASS> DI void lru_tile(KP p, int tile, LAS float* scr, int lane) {
    asm volatile("" : "+v"(lane));
    unsigned char* ws = p->ws;
    const int b = tile >> 9, g = (tile >> 6) & 7, chunk = tile & 63;
    const int r = lane & 31, h = lane >> 5;
    const bf16_t* Z = (const bf16_t*)(ws + A_Z);
    const bf16_t* WrT = (const bf16_t*)(ws + W_GATE) + g * 4096; const bf16_t* WiT = WrT + 32768;
    const float* conv_w = p->in[8]; const float* conv_b = p->in[9]; const float* b_r = p->in[11]; const float* b_i = p->in[13]; const float* lam = (const float*)(ws + A_LSL);
    float* carries = (float*)(ws + A_CARRY);
    LAS float* la = scr; LAS float* lu = scr + 64 * 33; LAS float* cwl = scr + 2 * 64 * 33;
    if (PASS == 1) {
#pragma unroll
        for (int tap = 0; tap < 4; ++tap) cwl[tap * 64 + lane] = conv_w[tap * 512 + g * 64 + lane];
        cwl[256 + lane] = conv_b[g * 64 + lane];
    }
    unsigned* stash = (g < 4) ? (unsigned*)((unsigned char*)p->out + 36 * MiB) : (unsigned*)(ws + 176 * MiB);
    float hstate = 0.f, pprod = 1.f;
    const int cch = g * 64 + lane;
    if (PASS == 2) {
        const f32x2_t* cp = (const f32x2_t*)carries + (size_t)(b * 64) * 512 + cch;
#pragma unroll 1
        for (int hb = 0; hb < chunk; hb += 32) {
            unsigned long long cr[32];
#pragma unroll
            for (int q = 0; q < 32; ++q) { const f32x2_t* cq = cp + (size_t)(hb + q) * 512; asm volatile("global_load_dwordx2 %0, %1, off" : "=v"(cr[q]) : "v"(cq)); }
            asm volatile("s_waitcnt vmcnt(0)" : "+v"(cr[0]), "+v"(cr[1]), "+v"(cr[2]), "+v"(cr[3]), "+v"(cr[4]), "+v"(cr[5]), "+v"(cr[6]), "+v"(cr[7]),
                                                "+v"(cr[8]), "+v"(cr[9]), "+v"(cr[10]), "+v"(cr[11]), "+v"(cr[12]), "+v"(cr[13]), "+v"(cr[14]), "+v"(cr[15]));
            asm volatile("" : "+v"(cr[16]), "+v"(cr[17]), "+v"(cr[18]), "+v"(cr[19]), "+v"(cr[20]), "+v"(cr[21]), "+v"(cr[22]), "+v"(cr[23]),
                              "+v"(cr[24]), "+v"(cr[25]), "+v"(cr[26]), "+v"(cr[27]), "+v"(cr[28]), "+v"(cr[29]), "+v"(cr[30]), "+v"(cr[31]));
#pragma unroll
            for (int q = 0; q < 32; ++q) { const float ca = __uint_as_float((unsigned)cr[q]), cb = __uint_as_float((unsigned)(cr[q] >> 32)); if (hb + q < chunk) hstate = ca * hstate + cb; }
        }
    }
#pragma unroll 1
    for (int tb = 0; tb < 2; ++tb) {
        if (PASS == 1) {
        int zz = 0; asm volatile("" : "+v"(zz));
        conv_w += zz; conv_b += zz; b_r += zz; b_i += zz; lam += zz; WrT += zz; WiT += zz;
        const int spos = chunk * 64 + tb * 32 + r;
        const size_t grow = (size_t)b * SEQ + spos;
        float xc[32];
        unsigned long long zx[8][4];
#pragma unroll
        for (int gi = 0; gi < 8; ++gi)
#pragma unroll
            for (int tap = 0; tap < 4; ++tap) {
                const bool ok = (spos - 3 + tap) >= 0;
                const bf16_t* zp = Z + (ok ? (grow - 3 + tap) : grow) * EINP + (g * 64 + 16 * (gi >> 1) + 8 * (gi & 1) + 4 * h);
                asm volatile("global_load_dwordx2 %0, %1, off" : "=v"(zx[gi][tap]) : "v"(zp));
            }
        asm volatile("s_waitcnt vmcnt(0)" : "+v"(zx[0][0]), "+v"(zx[0][1]), "+v"(zx[0][2]), "+v"(zx[0][3]), "+v"(zx[1][0]), "+v"(zx[1][1]), "+v"(zx[1][2]), "+v"(zx[1][3]),
                                            "+v"(zx[2][0]), "+v"(zx[2][1]), "+v"(zx[2][2]), "+v"(zx[2][3]), "+v"(zx[3][0]), "+v"(zx[3][1]), "+v"(zx[3][2]), "+v"(zx[3][3]));
        asm volatile("" : "+v"(zx[4][0]), "+v"(zx[4][1]), "+v"(zx[4][2]), "+v"(zx[4][3]), "+v"(zx[5][0]), "+v"(zx[5][1]), "+v"(zx[5][2]), "+v"(zx[5][3]),
                          "+v"(zx[6][0]), "+v"(zx[6][1]), "+v"(zx[6][2]), "+v"(zx[6][3]), "+v"(zx[7][0]), "+v"(zx[7][1]), "+v"(zx[7][2]), "+v"(zx[7][3]));
#pragma unroll
        for (int gi = 0; gi < 8; ++gi) {
            const int chl0 = 16 * (gi >> 1) + 8 * (gi & 1) + 4 * h;
            f32x4 a4 = *(const LAS f32x4*)(cwl + 256 + chl0);
#pragma unroll
            for (int tap = 0; tap < 4; ++tap) {
                f32x4 cw = *(const LAS f32x4*)(cwl + tap * 64 + chl0);
                if ((spos - 3 + tap) < 0) cw = (f32x4){0.f, 0.f, 0.f, 0.f};
                const unsigned lo = (unsigned)zx[gi][tap], hi = (unsigned)(zx[gi][tap] >> 32);
                a4[0] += __uint_as_float(lo << 16) * cw[0]; a4[1] += __uint_as_float(lo & 0xffff0000u) * cw[1];
                a4[2] += __uint_as_float(hi << 16) * cw[2]; a4[3] += __uint_as_float(hi & 0xffff0000u) * cw[3];
            }
#pragma unroll
            for (int e = 0; e < 4; ++e) xc[gi * 4 + e] = a4[e];
        }
        f32x16 R[2], I[2];
#pragma unroll
        for (int mb = 0; mb < 2; ++mb) { R[mb] = (f32x16){}; I[mb] = (f32x16){}; }
#pragma unroll
        for (int ks = 0; ks < 4; ++ks) {
            u32x4 bw; bw.x = pk2(xc[ks * 8 + 0], xc[ks * 8 + 1]); bw.y = pk2(xc[ks * 8 + 2], xc[ks * 8 + 3]); bw.z = pk2(xc[ks * 8 + 4], xc[ks * 8 + 5]); bw.w = pk2(xc[ks * 8 + 6], xc[ks * 8 + 7]);
            const bf16x8 bfrag = __builtin_bit_cast(bf16x8, bw);
#pragma unroll
            for (int mb = 0; mb < 2; ++mb) {
                const bf16_t* wr_ = WrT + (mb * 32 + r) * 64 + 16 * ks + 4 * h; const bf16_t* wi_ = WiT + (mb * 32 + r) * 64 + 16 * ks + 4 * h;
                const u32x2 r0 = *(const u32x2*)wr_, r1 = *(const u32x2*)(wr_ + 8), i0 = *(const u32x2*)wi_, i1 = *(const u32x2*)(wi_ + 8);
                const bf16x8 ar = __builtin_bit_cast(bf16x8, (u32x4){r0.x, r0.y, r1.x, r1.y}); const bf16x8 ai = __builtin_bit_cast(bf16x8, (u32x4){i0.x, i0.y, i1.x, i1.y});
                R[mb] = MFMA32(ar, bfrag, R[mb]); I[mb] = MFMA32(ai, bfrag, I[mb]);
            }
        }
#pragma unroll
        for (int mb = 0; mb < 2; ++mb)
#pragma unroll
            for (int i4 = 0; i4 < 4; ++i4) {
                const int chl = 32 * mb + 8 * i4 + 4 * h, chg = g * 64 + chl;
                const f32x4 br = *(const f32x4*)(b_r + chg), bi = *(const f32x4*)(b_i + chg), lm = *(const f32x4*)(lam + chg);
#pragma unroll
                for (int e = 0; e < 4; ++e) {
                    const int i = 4 * i4 + e;
                    const float rg = fsigmoid(R[mb][i] + br[e]), ig = fsigmoid(I[mb][i] + bi[e]);
                    const float a = ex2(rg * lm[e]), u = __builtin_amdgcn_sqrtf(fmaxf(1.f - a * a, 0.f)) * (ig * xc[16 * mb + i]);
                    la[(chl + e) * 33 + r] = a; lu[(chl + e) * 33 + r] = u;
                }
            }
        }
        unsigned short gbv[32]; unsigned stw[32];
        const size_t srow0 = ((size_t)b * SEQ + chunk * 64 + tb * 32) * 256 + (cch & 255);
        if (PASS == 2) {
#pragma unroll
            for (int t = 0; t < 32; ++t) { stw[t] = stash[srow0 + (size_t)t * 256]; gbv[t] = Z[((size_t)b * SEQ + chunk * 64 + tb * 32 + t) * EINP + 512 + cch]; }
        }
#pragma unroll
        for (int t = 0; t < 32; ++t) {
            float a, u;
            if (PASS == 1) { a = la[lane * 33 + t]; u = lu[lane * 33 + t]; stash[srow0 + (size_t)t * 256] = pk2(1.f - a, u); pprod *= a; }
            else { a = 1.f - __uint_as_float(stw[t] << 16); u = __uint_as_float(stw[t] & 0xffff0000u); }
            hstate = a * hstate + u;
            if (PASS == 2) {
                const size_t row = (size_t)b * SEQ + chunk * 64 + tb * 32 + t;
                ((bf16_t*)(ws + A_Y))[row * D + cch] = (bf16_t)(pk2(hstate * gelu_tanh(bf2f(gbv[t])), 0.f) & 0xffffu);
            }
        }
    }
    if (PASS == 1) { f32x2_t c = {pprod, hstate}; *(f32x2_t*)(carries + ((size_t)(b * 64 + chunk) * 512 + cch) * 2) = c; }
}

constexpr int AT_R = 4, AT_KSLOT = 8192, AT_VOFF = AT_R * AT_KSLOT, AT_VSLOT = 16384, AT_COFF = AT_VOFF + AT_R * AT_VSLOT, AT_WSF = AT_COFF + 8 * AT_R * 256, AT_QOFF = AT_WSF + 2048;
DI float max3f(float a, float b, float c) { return __builtin_fmaxf(__builtin_fmaxf(a, b), c); }
DI void glds16(const void* gsrc, unsigned lds_dst) { unsigned keep;
    asm volatile("s_mov_b32 %0, m0\n\ts_mov_b32 m0, %2\n\ts_nop 0\n\tglobal_load_lds_dwordx4 %1, off\n\ts_mov_b32 m0, %0" : "=&s"(keep) : "v"(gsrc), "s"(lds_dst) : "memory"); }
DI void glds4(const void* gsrc, unsigned lds_dst) { unsigned keep;
    asm volatile("s_mov_b32 %0, m0\n\ts_mov_b32 m0, %2\n\ts_nop 0\n\tglobal_load_lds_dword %1, off\n\ts_mov_b32 m0, %0" : "=&s"(keep) : "v"(gsrc), "s"(lds_dst) : "memory"); }
#define AT_WAIT_BAR(N) asm volatile("s_waitcnt vmcnt(" #N ") lgkmcnt(0)\n\ts_barrier" ::: "memory")
template <int DV, bool BIAS> DI void attn_pass(f32x16 (&o)[DV / 32], const bf16_t* Qb, const bf16_t* Kb, const bf16_t* Vb, int pitch, const float* cum, const float* kmaxp, int q0, LAS unsigned char* lds, int tid, int lane, int wave) {
    constexpr int VROWB = DV * 2, NDB = DV / 32, NVD = DV / 64;
#ifndef AT_QLDS128
#define AT_QLDS128 1
#endif
#ifndef AT_LMFMA128
#define AT_LMFMA128 0
#endif
    constexpr bool QLDS = (DV == 128) && AT_QLDS128, LMFMA = (DV != 128) || AT_LMFMA128;
    constexpr float THR = 8.f;
    const int r = lane & 31, h = lane >> 5, i16 = lane & 15, tq = i16 >> 2, tp = i16 & 3, blk = (lane >> 4) & 1;
    const int NT = (q0 + 256) / 64;
    const int qw0 = q0 + 32 * wave;
    const int NH = qw0 / 32 + 1;
    LAS float* wsf = (LAS float*)(lds + AT_WSF) + wave * 64;
    const unsigned lds0 = (unsigned)(uintptr_t)lds;
    bf16x8 qf[4];
    LAS unsigned char* qs = lds + AT_QOFF + wave * 4608 + r * 144 + h * 16;
#pragma unroll
    for (int ks = 0; ks < 4; ++ks) { qf[ks] = *(const bf16x8*)((Qb + (size_t)qw0 * pitch) + (unsigned)(r * pitch + 16 * ks + 8 * h)); if (QLDS) *(LAS bf16x8*)(qs + ks * 32) = qf[ks]; }
#pragma unroll
    for (int db = 0; db < NDB; ++db) o[db] = (f32x16){};
    float mhat = -INFINITY, lrun = 0.f; f32x16 lacc = (f32x16){};
    const bf16x8 ones8 = (bf16x8){0x3F80, 0x3F80, 0x3F80, 0x3F80, 0x3F80, 0x3F80, 0x3F80, 0x3F80};
    const unsigned koff_ = (unsigned)((wave * 8 + (lane >> 3)) * pitch + (((lane & 7) ^ ((lane >> 3) & 7)) * 8));
    unsigned voff_[NVD];
    if (NVD == 1) voff_[0] = koff_;
    else {
#pragma unroll
        for (int i_ = 0; i_ < NVD; ++i_) { const int row_ = (i_ * 8 + wave) * 4 + (lane >> 4); voff_[i_] = (unsigned)(row_ * pitch + (((lane & 15) ^ (row_ & 7)) * 8)); }
    }
#define AT_ISSUE(t, slot) do { const size_t tb_ = (size_t)(64 * (t)) * pitch; \
        glds16(Kb + tb_ + koff_, (unsigned)__builtin_amdgcn_readfirstlane(lds0 + (slot) * AT_KSLOT + wave * 1024)); \
        _Pragma("unroll") for (int i_ = 0; i_ < NVD; ++i_) glds16(Vb + tb_ + voff_[i_], (unsigned)__builtin_amdgcn_readfirstlane(lds0 + AT_VOFF + (slot) * AT_VSLOT + (i_ * 8 + wave) * 1024)); \
        if (BIAS) glds4(cum + 64 * (t) + lane, (unsigned)__builtin_amdgcn_readfirstlane(lds0 + AT_COFF + (wave * AT_R + (slot)) * 256)); \
        else if (NVD == 1) glds4(Kb + tb_ + koff_, (unsigned)__builtin_amdgcn_readfirstlane(lds0 + AT_COFF + (wave * AT_R + (slot)) * 256)); } while (0)
    const int kx_ = r & 7;
#define AT_QK(S, slot, half) do { const LAS unsigned char* KB_ = lds + (slot) * AT_KSLOT + (32 * (half) + r) * 128; \
        if (BIAS) { _Pragma("unroll") for (int g4 = 0; g4 < 4; ++g4) { const f32x4 c_ = *(const LAS f32x4*)(lds + AT_COFF + (wave * AT_R + (slot)) * 256 + (32 * (half) + 8 * g4 + 4 * h) * 4); \
            S[4 * g4] = c_[0]; S[4 * g4 + 1] = c_[1]; S[4 * g4 + 2] = c_[2]; S[4 * g4 + 3] = c_[3]; } } else S = (f32x16){}; \
        _Pragma("unroll") for (int ks = 0; ks < 4; ++ks) S = MFMA32(*(const LAS bf16x8*)(KB_ + (((2 * ks + h) ^ kx_) * 16)), QLDS ? *(const LAS bf16x8*)(qs + ks * 32) : qf[ks], S); } while (0)
    const int vx_ = 4 * h + tq;
#define AT_STEP(S, vslot, half, MASK) do { \
        if (MASK) { _Pragma("unroll") for (int i = 0; i < 16; ++i) if (crow(i, h) > r) S[i] = -INFINITY; } \
        float rm_ = max3f(S[0], S[1], S[2]); \
        _Pragma("unroll") for (int i = 3; i < 15; i += 2) rm_ = max3f(rm_, S[i], S[i + 1]); \
        rm_ = fmaxf(rm_, S[15]); rm_ = fmaxf(rm_, __shfl_xor(rm_, 32)); \
        if (BIAS && !__any(rm_ >= mlb)) break;     \
        if (__any(rm_ > mhat + THR)) { const float mnew_ = fmaxf(mhat, rm_); const float f_ = ex2(mhat - mnew_); mhat = mnew_; lrun *= f_; \
            if (h == 0) wsf[r] = f_; \
            _Pragma("unroll") for (int i4 = 0; i4 < 4; ++i4) { const f32x4 fv_ = *(const LAS f32x4*)(wsf + 8 * i4 + 4 * h); \
                _Pragma("unroll") for (int e = 0; e < 4; ++e) { if (LMFMA) asm volatile("v_mul_f32 %0, %0, %1" : "+v"(lacc[4 * i4 + e]) : "v"(fv_[e])); \
                    _Pragma("unroll") for (int db = 0; db < NDB; ++db) asm volatile("v_mul_f32 %0, %0, %1" : "+v"(o[db][4 * i4 + e]) : "v"(fv_[e])); } } } \
        _Pragma("unroll") for (int i = 0; i < 16; ++i) S[i] = ex2(S[i] - mhat); \
        if (!LMFMA) { float rs_ = 0.f; _Pragma("unroll") for (int i = 0; i < 16; ++i) rs_ += S[i]; lrun += rs_; } \
        if (NDB == 4) __builtin_amdgcn_sched_barrier(0); \
        _Pragma("unroll") for (int s = 0; s < 2; ++s) { u32x4 pw_; pw_.x = pk2(S[8 * s], S[8 * s + 1]); pw_.y = pk2(S[8 * s + 2], S[8 * s + 3]); pw_.z = pk2(S[8 * s + 4], S[8 * s + 5]); pw_.w = pk2(S[8 * s + 6], S[8 * s + 7]); \
            const bf16x8 pa_ = __builtin_bit_cast(bf16x8, pw_); if (LMFMA) lacc = MFMA32(pa_, ones8, lacc); \
            _Pragma("unroll") for (int db = 0; db < NDB; ++db) { const LAS unsigned char* vp_ = lds + AT_VOFF + (vslot) * AT_VSLOT + (32 * (half) + 16 * s + 4 * h + tq) * VROWB + (((db * 4 + blk * 2 + (tp >> 1)) ^ vx_) * 16) + (tp & 1) * 8; \
                const s16x4 lo_ = vtr(vp_), hi_ = vtr(vp_ + 8 * VROWB); o[db] = MFMA32(pa_, cat8(lo_, hi_), o[db]); } \
            if (NDB == 4) __builtin_amdgcn_sched_barrier(0); } } while (0)
    float mlb = -INFINITY;
    if (BIAS) {
        f32x16 Sd;
#pragma unroll
        for (int g4 = 0; g4 < 4; ++g4) { const f32x4 c_ = *(const f32x4*)(cum + qw0 + 8 * g4 + 4 * h); Sd[4 * g4] = c_[0]; Sd[4 * g4 + 1] = c_[1]; Sd[4 * g4 + 2] = c_[2]; Sd[4 * g4 + 3] = c_[3]; }
#pragma unroll
        for (int ks = 0; ks < 4; ++ks) { const bf16x8 kd = *(const bf16x8*)((Kb + (size_t)qw0 * pitch) + (unsigned)(r * pitch + 16 * ks + 8 * h)); Sd = MFMA32(kd, qf[ks], Sd); }
#pragma unroll
        for (int i = 0; i < 16; ++i) if (crow(i, h) <= r) mlb = fmaxf(mlb, Sd[i]);
        mlb = fmaxf(mlb, __shfl_xor(mlb, 32)) - 40.f;
    }
    int t0 = 0;
    if (BIAS) {
        float qn2 = 0.f;
#pragma unroll
        for (int ks = 0; ks < 4; ++ks)
#pragma unroll
            for (int e = 0; e < 8; ++e) { const float qv = bf2f((unsigned short)qf[ks][e]); qn2 += qv * qv; }
        qn2 += __shfl_xor(qn2, 32);
        float thr = mlb - __builtin_amdgcn_sqrtf(qn2 * kmaxp[0]) * 1.001f - 0.01f;
#pragma unroll
        for (int x = 1; x < 32; x <<= 1) thr = fminf(thr, __shfl_xor(thr, x));
        LAS float* wg = (LAS float*)(lds + AT_WSF);
        if (lane == 0) wsf[0] = thr;
        asm volatile("s_waitcnt lgkmcnt(0)\n\ts_barrier" ::: "memory");
        float thrw = wg[0];
#pragma unroll
        for (int w = 1; w < 8; ++w) thrw = fminf(thrw, wg[w * 64]);
        const float cend = (lane < NT) ? cum[64 * lane + 63] : INFINITY;
        const unsigned long long need = __ballot(cend >= thrw);
        t0 = need ? (int)__builtin_ctzll(need) : 0;
        if (t0 > q0 / 64) t0 = q0 / 64;
        asm volatile("s_waitcnt lgkmcnt(0)\n\ts_barrier" ::: "memory");
    }
    AT_ISSUE(t0, 0); AT_ISSUE(t0 + 1, 1); AT_ISSUE(t0 + 2, 2);
    AT_WAIT_BAR(3);
    constexpr bool PIPE = (DV != 128);
    f32x16 SA, SB;
    if (PIPE) AT_QK(SA, 0, 0);
    int sl = 0, t = t0;
    const int TA = (NH - 1) >> 1;
#define AT_PRE() const int sl1 = (sl + 1) & 3; if (t + 3 < NT) AT_ISSUE(t + 3, (sl + 3) & 3)
#define AT_POST() do { if (t + 3 < NT) AT_WAIT_BAR(3); else AT_WAIT_BAR(0); sl = sl1; } while (0)
    if (PIPE) {
#pragma unroll 1
        for (; t < TA; ++t) { AT_PRE(); AT_QK(SB, sl, 1); AT_STEP(SA, sl, 0, false); AT_QK(SA, sl1, 0); AT_STEP(SB, sl, 1, false); AT_POST(); }
        {
            AT_PRE();
            if (NH - 2 * TA == 2) { AT_QK(SB, sl, 1); AT_STEP(SA, sl, 0, false); AT_STEP(SB, sl, 1, true); }
            else { AT_STEP(SA, sl, 0, true); }
            AT_POST(); ++t;
        }
#pragma unroll 1
        for (; t < NT; ++t) { AT_PRE(); AT_POST(); }
    } else {
#pragma unroll 1
        for (; t < NT; ++t) { AT_PRE();
            if (2 * t < NH) { AT_QK(SA, sl, 0); AT_STEP(SA, sl, 0, (2 * t == NH - 1)); }
            if (2 * t + 1 < NH) { AT_QK(SA, sl, 1); AT_STEP(SA, sl, 1, (2 * t + 1 == NH - 1)); }
            AT_POST(); }
    }
#undef AT_PRE
#undef AT_POST
#undef AT_ISSUE
#undef AT_QK
#undef AT_STEP
    if (LMFMA) {
#pragma unroll
        for (int i = 0; i < 16; ++i) { const float inv = __builtin_amdgcn_rcpf(lacc[i]);
#pragma unroll
            for (int db = 0; db < NDB; ++db) o[db][i] *= inv; }
    } else {
        lrun += __shfl_xor(lrun, 32);
        if (h == 0) wsf[r] = __builtin_amdgcn_rcpf(lrun);
#pragma unroll
        for (int i4 = 0; i4 < 4; ++i4) { const f32x4 f = *(const LAS f32x4*)(wsf + 8 * i4 + 4 * h);
#pragma unroll
            for (int e = 0; e < 4; ++e)
#pragma unroll
                for (int db = 0; db < NDB; ++db) o[db][4 * i4 + e] *= f[e]; }
    }
}

constexpr int AO_KSTR = 144, AO_VOFF = 9216, AO_COFF = 9216 + 17408, AO_BUF = AO_COFF + 256, AO_WSF = 2 * AO_BUF;
template <int DV, bool BIAS> DI void attn_pass_old(f32x16 (&o)[DV / 32], const bf16_t* Qb, const bf16_t* Kb, const bf16_t* Vb, int pitch, const float* cum, int q0, LAS unsigned char* lds, int tid, int lane, int wave) {
    constexpr int VSTR = (DV + 8) * 2, NDB = DV / 32, NVL = DV / 64;
    const int r = lane & 31, h = lane >> 5, i16 = lane & 15, tq = i16 >> 2, tp = i16 & 3, blk = (lane >> 4) & 1;
    const int NT = (q0 + 256) / 64;
    const int qw0 = q0 + 32 * wave;
    LAS float* wsf = (LAS float*)(lds + AO_WSF) + wave * 64;
    bf16x8 qf[4];
#pragma unroll
    for (int ks = 0; ks < 4; ++ks) qf[ks] = *(const bf16x8*)(Qb + (size_t)(qw0 + r) * pitch + 16 * ks + 8 * h);
    float cq = 0.f; if (BIAS) cq = cum[qw0 + r];
#pragma unroll
    for (int db = 0; db < NDB; ++db) o[db] = (f32x16){};
    float mrun = -INFINITY; f32x16 lacc = (f32x16){};
    const bf16x8 ones8 = (bf16x8){0x3F80, 0x3F80, 0x3F80, 0x3F80, 0x3F80, 0x3F80, 0x3F80, 0x3F80};
    u32x4 sk, sv[NVL]; float sc = 0.f;
    const int krow_ = tid >> 3, kch = tid & 7;
#define AO_LOAD(t) do { sk = *(const u32x4*)(Kb + (size_t)(64 * (t) + krow_) * pitch + kch * 8); \
        _Pragma("unroll") for (int i_ = 0; i_ < NVL; ++i_) { const int idx_ = tid + 512 * i_; const int vr_ = (NVL == 1) ? (idx_ >> 3) : (idx_ >> 4), vc_ = (NVL == 1) ? (idx_ & 7) : (idx_ & 15); \
            sv[i_] = *(const u32x4*)(Vb + (size_t)(64 * (t) + vr_) * pitch + vc_ * 8); } \
        if (BIAS && tid < 64) sc = cum[64 * (t) + tid]; } while (0)
#define AO_STORE(buf) do { LAS unsigned char* B_ = lds + (buf) * AO_BUF; *(LAS u32x4*)(B_ + krow_ * AO_KSTR + kch * 16) = sk; \
        _Pragma("unroll") for (int i_ = 0; i_ < NVL; ++i_) { const int idx_ = tid + 512 * i_; const int vr_ = (NVL == 1) ? (idx_ >> 3) : (idx_ >> 4), vc_ = (NVL == 1) ? (idx_ & 7) : (idx_ & 15); \
            *(LAS u32x4*)(B_ + AO_VOFF + vr_ * VSTR + vc_ * 16) = sv[i_]; } \
        if (BIAS && tid < 64) *(LAS float*)(B_ + AO_COFF + tid * 4) = sc; } while (0)
    AO_LOAD(0); AO_STORE(0); __syncthreads();
#pragma unroll 1
    for (int t = 0; t < NT; ++t) {
        const int buf = t & 1;
        if (t + 1 < NT) AO_LOAD(t + 1);
        if (64 * t <= qw0 + 31) {
            const LAS unsigned char* KB = lds + buf * AO_BUF; const LAS unsigned char* VB = KB + AO_VOFF;
            f32x16 p0 = (f32x16){}, p1 = (f32x16){};
#pragma unroll
            for (int ks = 0; ks < 4; ++ks) {
                const bf16x8 k0 = *(const LAS bf16x8*)(KB + r * AO_KSTR + ks * 32 + h * 16), k1 = *(const LAS bf16x8*)(KB + (32 + r) * AO_KSTR + ks * 32 + h * 16);
                p0 = MFMA32(k0, qf[ks], p0); p1 = MFMA32(k1, qf[ks], p1);
            }
            if (BIAS) {
#pragma unroll
                for (int g4 = 0; g4 < 4; ++g4) { const f32x4 c0 = *(const LAS f32x4*)(KB + AO_COFF + (8 * g4 + 4 * h) * 4), c1 = *(const LAS f32x4*)(KB + AO_COFF + (32 + 8 * g4 + 4 * h) * 4);
#pragma unroll
                    for (int e = 0; e < 4; ++e) { p0[4 * g4 + e] += cq - c0[e]; p1[4 * g4 + e] += cq - c1[e]; } }
            }
            if (64 * t + 63 > qw0) {
                const int qpos = qw0 + r;
#pragma unroll
                for (int i = 0; i < 16; ++i) { const int kp = 64 * t + crow(i, h); if (kp > qpos) p0[i] = -INFINITY; if (kp + 32 > qpos) p1[i] = -INFINITY; }
            }
            float mx = fmaxf(p0[0], p1[0]);
#pragma unroll
            for (int i = 1; i < 16; ++i) mx = max3f(mx, p0[i], p1[i]);
            mx = fmaxf(mx, __shfl_xor(mx, 32));
            if (__any(mx > mrun + 8.f)) {
                const float mnew = fmaxf(mrun, mx); const float alpha = ex2(mrun - mnew); mrun = mnew;
                if (h == 0) wsf[r] = alpha;
#pragma unroll
                for (int i4 = 0; i4 < 4; ++i4) { const f32x4 f = *(const LAS f32x4*)(wsf + 8 * i4 + 4 * h);
#pragma unroll
                    for (int e = 0; e < 4; ++e) { lacc[4 * i4 + e] *= f[e];
#pragma unroll
                        for (int db = 0; db < NDB; ++db) o[db][4 * i4 + e] *= f[e]; } }
            }
#pragma unroll
            for (int i = 0; i < 16; ++i) { p0[i] = ex2(p0[i] - mrun); p1[i] = ex2(p1[i] - mrun); }
#pragma unroll
            for (int s = 0; s < 4; ++s) {
                const int s8 = 8 * (s & 1);
                u32x4 pw;
                if (s < 2) { pw.x = pk2(p0[s8], p0[s8 + 1]); pw.y = pk2(p0[s8 + 2], p0[s8 + 3]); pw.z = pk2(p0[s8 + 4], p0[s8 + 5]); pw.w = pk2(p0[s8 + 6], p0[s8 + 7]); }
                else       { pw.x = pk2(p1[s8], p1[s8 + 1]); pw.y = pk2(p1[s8 + 2], p1[s8 + 3]); pw.z = pk2(p1[s8 + 4], p1[s8 + 5]); pw.w = pk2(p1[s8 + 6], p1[s8 + 7]); }
                const bf16x8 pa = __builtin_bit_cast(bf16x8, pw);
                lacc = MFMA32(pa, ones8, lacc);
#pragma unroll
                for (int db = 0; db < NDB; ++db) {
                    const LAS unsigned char* vp = VB + (16 * s + 4 * h + tq) * VSTR + (db * 32 + 16 * blk + 4 * tp) * 2;
                    const s16x4 lo = vtr(vp), hi = vtr(vp + 8 * VSTR);
                    o[db] = MFMA32(pa, cat8(lo, hi), o[db]);
                }
                __builtin_amdgcn_sched_barrier(0);
            }
        }
        if (t + 1 < NT) AO_STORE(buf ^ 1);
        __syncthreads();
    }
#undef AO_LOAD
#undef AO_STORE
#pragma unroll
    for (int i = 0; i < 16; ++i) { const float inv = __builtin_amdgcn_rcpf(lacc[i]);
#pragma unroll
        for (int db = 0; db < NDB; ++db) o[db][i] *= inv; }
}

DI void fox_unit(KP p, int bh, int qb, LAS unsigned char* lds, int tid, int lane, int wave) {
    asm volatile("" : "+v"(tid), "+v"(lane));
    unsigned char* ws = p->ws; const int b = bh >> 3, hd = bh & 7, r = lane & 31, h = lane >> 5;
    const bf16_t* Zb = (const bf16_t*)(ws + A_Z) + (size_t)b * SEQ * EINP;
    f32x16 o[2];
    attn_pass<64, true>(o, Zb + 1024 + hd * 64, Zb + 1536 + hd * 64, Zb + 2048 + hd * 64, EINP, (const float*)(ws + A_LF) + (size_t)bh * SEQ, (const float*)(ws + A_KMAX) + bh, qb * 256, lds, tid, lane, wave);
    unsigned goff = 114688u + (unsigned)wave * 4608u;
    asm volatile("" : "+v"(goff));
    LAS unsigned char* stg = lds + goff;
#pragma unroll
    for (int i = 0; i < 16; ++i)
#pragma unroll
        for (int db = 0; db < 2; ++db) *(LAS bf16_t*)(stg + (crow(i, 0) + 4 * h) * 144 + (db * 32 + r) * 2) = (bf16_t)(pk2(o[db][i], 0.f) & 0xffffu);
    asm volatile("s_waitcnt lgkmcnt(0)" ::: "memory");
    bf16_t* Y = (bf16_t*)(ws + A_Y) + ((size_t)(b * SEQ + qb * 256 + 32 * wave) * D + 512 + hd * 64);
#pragma unroll
    for (int it = 0; it < 4; ++it) { const int row = it * 8 + (lane >> 3), ch = lane & 7; const u32x4 w = *(const LAS u32x4*)(stg + row * 144 + ch * 16); *(u32x4*)(Y + (size_t)row * D + ch * 8) = w; }
}
DI void diff_unit(KP p, int bh, int qb, float lam, LAS unsigned char* lds, int tid, int lane, int wave) {
    asm volatile("" : "+v"(tid), "+v"(lane));
    unsigned char* ws = p->ws; const int b = bh >> 3, hd = bh & 7, r = lane & 31, h = lane >> 5;
    const bf16_t* Zb = (const bf16_t*)(ws + A_Z) + (size_t)b * SEQ * OIN;
    unsigned soff = 69632u + (unsigned)wave * 8192u + (unsigned)lane * 4u;
    f32x16 o[4];
    attn_pass_old<128, false>(o, Zb + hd * 128, Zb + 1024 + hd * 128, Zb + 2048 + hd * 128, OIN, nullptr, qb * 256, lds, tid, lane, wave);
    asm volatile("" : "+v"(soff));
    {
        LAS unsigned* st = (LAS unsigned*)(lds + soff);
#pragma unroll
        for (int i = 0; i < 16; ++i) { st[(2 * i) * 64] = pk2(o[0][i], o[1][i]); st[(2 * i + 1) * 64] = pk2(o[2][i], o[3][i]); }
    }
    asm volatile("" : "+v"(soff) :: "memory");
    attn_pass_old<128, false>(o, Zb + hd * 128 + 64, Zb + 1024 + hd * 128 + 64, Zb + 2048 + hd * 128, OIN, nullptr, qb * 256, lds, tid, lane, wave);
    const float* ng = p->in[22];
    const float lambda_init = 0.8f - 0.6f * 0.7408182206817179f;
    float gsc[4];
#pragma unroll
    for (int db = 0; db < 4; ++db) gsc[db] = ng[db * 32 + r] * (1.f - lambda_init);
    unsigned goff = (unsigned)wave * 8704u;
    asm volatile("" : "+v"(soff), "+v"(goff));
    const LAS unsigned* st = (const LAS unsigned*)(lds + soff);
    LAS unsigned char* stg = lds + goff;
#pragma unroll
    for (int i = 0; i < 16; ++i) {
        float v[4], ss = 0.f;
        const unsigned w0 = st[(2 * i) * 64], w1 = st[(2 * i + 1) * 64];
        const float o0[4] = {__uint_as_float(w0 << 16), __uint_as_float(w0 & 0xffff0000u), __uint_as_float(w1 << 16), __uint_as_float(w1 & 0xffff0000u)};
#pragma unroll
        for (int db = 0; db < 4; ++db) { v[db] = o0[db] - lam * o[db][i]; ss += v[db] * v[db]; }
#pragma unroll
        for (int x = 1; x < 32; x <<= 1) ss += __shfl_xor(ss, x);
        const float rn = rsqrtf(ss * (1.f / 128.f) + EPS);
#pragma unroll
        for (int db = 0; db < 4; ++db) *(LAS bf16_t*)(stg + (crow(i, 0) + 4 * h) * 272 + (db * 32 + r) * 2) = (bf16_t)(pk2(v[db] * rn * gsc[db], 0.f) & 0xffffu);
        __builtin_amdgcn_sched_barrier(0);
    }
    asm volatile("s_waitcnt lgkmcnt(0)" ::: "memory");
    bf16_t* Y = (bf16_t*)(ws + A_Y) + ((size_t)(b * SEQ + qb * 256 + 32 * wave) * D + hd * 128);
#pragma unroll
    for (int it = 0; it < 8; ++it) { const int row = it * 4 + (lane >> 4), ch = lane & 15; const u32x4 w = *(const LAS u32x4*)(stg + row * 272 + ch * 16); *(u32x4*)(Y + (size_t)row * D + ch * 8) = w; }
    __syncthreads();
}

constexpr int XA_SLOT = 32768, XA_WSF = 3 * XA_SLOT;
DI void xattn_unit(const bf16_t* Q, const bf16_t* KV, bf16_t* O, int pm, int hd, LAS unsigned char* lds, int tid, int lane, int wave) {
    asm volatile("" : "+v"(tid), "+v"(lane));
    const int r = lane & 31, h = lane >> 5, i16 = lane & 15, tq = i16 >> 2, tp = i16 & 3, blk = (lane >> 4) & 1;
    const int b = pm >> 4;
    const bf16_t* Qrow = Q + (size_t)(pm * 256 + 32 * wave) * D + hd * 256;
    const bf16_t* Kb = KV + (size_t)(b * 256) * 2048 + hd * 256; const bf16_t* Vb = Kb + 1024;
    LAS float* wsf = (LAS float*)(lds + XA_WSF) + wave * 64;
    const unsigned lds0 = (unsigned)(uintptr_t)lds;
    bf16x8 qf[16];
#pragma unroll
    for (int ks = 0; ks < 16; ++ks) qf[ks] = Q ? *(const bf16x8*)(Qrow + (unsigned)(r * D + ks * 16 + 8 * h)) : *(const LAS bf16x8*)(lds + (32 * wave + r) * QL_STRIDE + (ks * 16 + 8 * h) * 2);
    if (!Q) { asm volatile("s_waitcnt lgkmcnt(0)" ::: "memory"); __syncthreads(); }
    const unsigned kofs = (unsigned)((wave * 8 + (lane >> 3)) * 2048 + (((lane & 7) ^ ((lane >> 3) & 7)) * 8));
    const unsigned vofs = (unsigned)((wave * 4 + (lane >> 4)) * 2048 + (((lane & 15) ^ (((wave & 1) * 4 + (lane >> 4)) & 7)) * 8));
#define XA_ISSUE(tl, slot) do { if ((tl) < 4) { _Pragma("unroll") for (int i_ = 0; i_ < 4; ++i_) glds16(Kb + (size_t)(i_ * 64) * 2048 + (tl) * 64 + kofs, (unsigned)__builtin_amdgcn_readfirstlane(lds0 + (slot) * XA_SLOT + (i_ * 8 + wave) * 1024)); } \
        else { const int dvh_ = ((tl) - 4) >> 1, kt_ = ((tl) - 4) & 1; _Pragma("unroll") for (int i_ = 0; i_ < 4; ++i_) glds16(Vb + (size_t)(kt_ * 128 + i_ * 32) * 2048 + dvh_ * 128 + vofs, (unsigned)__builtin_amdgcn_readfirstlane(lds0 + (slot) * XA_SLOT + (i_ * 8 + wave) * 1024)); } } while (0)
    f32x16 S[8];
#pragma unroll
    for (int kb = 0; kb < 8; ++kb) S[kb] = (f32x16){};
    asm volatile("s_waitcnt vmcnt(0)" ::: "memory");
    XA_ISSUE(0, 0); XA_ISSUE(1, 1);
    AT_WAIT_BAR(4);
    const int kx_ = r & 7, vx_ = 4 * h + tq;
#pragma unroll
    for (int kc = 0; kc < 4; ++kc) {
        const int slot = kc % 3;
        XA_ISSUE(kc + 2, (kc + 2) % 3);
#pragma unroll
        for (int ks = 0; ks < 4; ++ks) {
#pragma unroll
            for (int kb = 0; kb < 8; ++kb) { const bf16x8 kf = *(const LAS bf16x8*)(lds + slot * XA_SLOT + (kb * 32 + r) * 128 + (((2 * ks + h) ^ kx_) * 16)); S[kb] = MFMA32(kf, qf[kc * 4 + ks], S[kb]); }
            __builtin_amdgcn_sched_barrier(0);
        }
        AT_WAIT_BAR(4);
    }
    float mx = S[0][0];
#pragma unroll
    for (int kb = 0; kb < 8; ++kb)
#pragma unroll
        for (int i = 0; i < 16; ++i) mx = fmaxf(mx, S[kb][i]);
    mx = fmaxf(mx, __shfl_xor(mx, 32));
    float l = 0.f;
#pragma unroll
    for (int kb = 0; kb < 8; ++kb)
#pragma unroll
        for (int i = 0; i < 16; ++i) { S[kb][i] = ex2(S[kb][i] - mx); l += S[kb][i]; }
    l += __shfl_xor(l, 32);
    if (h == 0) wsf[r] = __builtin_amdgcn_rcpf(l);
    bf16x8 P[16];
#pragma unroll
    for (int kb = 0; kb < 8; ++kb)
#pragma unroll
        for (int s = 0; s < 2; ++s) { u32x4 pw; pw.x = pk2(S[kb][8 * s], S[kb][8 * s + 1]); pw.y = pk2(S[kb][8 * s + 2], S[kb][8 * s + 3]); pw.z = pk2(S[kb][8 * s + 4], S[kb][8 * s + 5]); pw.w = pk2(S[kb][8 * s + 6], S[kb][8 * s + 7]);
            P[2 * kb + s] = __builtin_bit_cast(bf16x8, pw); }
    unsigned ooff = (unsigned)(pm * 256 + 32 * wave + 4 * h) * D + hd * 256 + r;
#pragma unroll
    for (int dvh = 0; dvh < 2; ++dvh) {
        f32x16 o4[4];
#pragma unroll
        for (int db = 0; db < 4; ++db) o4[db] = (f32x16){};
#pragma unroll
        for (int kt = 0; kt < 2; ++kt) {
            const int tl = 4 + dvh * 2 + kt, slot = tl % 3;
            if (tl + 2 < 8) XA_ISSUE(tl + 2, (tl + 2) % 3);
#pragma unroll
            for (int s = 0; s < 8; ++s) {
#pragma unroll
                for (int db = 0; db < 4; ++db) {
                    const LAS unsigned char* vp = lds + slot * XA_SLOT + (16 * s + 4 * h + tq) * 256 + (((db * 4 + blk * 2 + (tp >> 1)) ^ vx_) * 16) + (tp & 1) * 8;
                    const s16x4 lo = vtr(vp), hi = vtr(vp + 8 * 256);
                    o4[db] = MFMA32(P[kt * 8 + s], cat8(lo, hi), o4[db]);
                }
                __builtin_amdgcn_sched_barrier(0);
            }
            if (tl + 2 < 8) AT_WAIT_BAR(4); else AT_WAIT_BAR(0);
        }
        float inv[16];
#pragma unroll
        for (int i4 = 0; i4 < 4; ++i4) { const f32x4 f = *(const LAS f32x4*)(wsf + 8 * i4 + 4 * h);
#pragma unroll
            for (int e = 0; e < 4; ++e) inv[4 * i4 + e] = f[e]; }
        asm volatile("" : "+v"(ooff));
        bf16_t* Orow = O + ooff;
#pragma unroll
        for (int i = 0; i < 16; ++i)
#pragma unroll
            for (int db = 0; db < 4; ++db) Orow[(size_t)crow(i, 0) * D + dvh * 128 + db * 32] = (bf16_t)(pk2(o4[db][i] * inv[i], 0.f) & 0xffffu);
    }
#undef XA_ISSUE
}

#define XB_TMO      128
#define XB_XCNT(j)  (256  + 64 * (j))
#define XB_XSUB(j)  (1280 + 64 * (j))
#define XB_XGEN(j)  (2304 + 64 * (j))
#define XB_TOP      3328
#define XB_TOPGEN   3392
#define XCD_BAR_WORDS 3456
#define XB_SPIN_CAP (1u << 18)

__device__ __forceinline__ unsigned xb_ld(unsigned* p)              { return __hip_atomic_load(p, __ATOMIC_RELAXED, __HIP_MEMORY_SCOPE_AGENT); }
__device__ __forceinline__ unsigned xb_add(unsigned* p, unsigned v) { return __hip_atomic_fetch_add(p, v, __ATOMIC_RELAXED, __HIP_MEMORY_SCOPE_AGENT); }
__device__ __forceinline__ unsigned xb_xcc_id() { return (unsigned)__builtin_amdgcn_s_getreg((3 << 11) | 20) & 0xFu; }
#define XB_SPIN(cond, bar) do { unsigned _sp = 0; while (cond) { __builtin_amdgcn_s_sleep(1); \
    if ((++_sp & 255u) == 0u) { if (xb_ld(&(bar)[XB_TMO])) break; if (_sp > XB_SPIN_CAP) { atomicAdd(&(bar)[XB_TMO], 1u); break; } } } } while (0)

struct XcdBarrier {
    unsigned* bar; unsigned x;
    volatile LAS unsigned* st;
};

__device__ __forceinline__ XcdBarrier xcd_barrier_post(unsigned* bar, volatile LAS unsigned* st) {
    XcdBarrier b; b.bar = bar; b.x = xb_xcc_id(); b.st = st;
    if (threadIdx.x == 0) (void)xb_add(&bar[XB_XCNT(b.x)], 1u);
    return b;
}
__device__ __forceinline__ void xcd_barrier_complete(unsigned* bar, unsigned x, unsigned& nloc, unsigned& nx) {
    const unsigned G = gridDim.x * gridDim.y * gridDim.z;
    unsigned sum, cnt, mine, sp = 0u;
    for (;;) {
        sum = 0u; cnt = 0u; mine = 0u;
#pragma unroll
        for (unsigned j = 0; j < 16; ++j) { const unsigned c = xb_ld(&bar[XB_XCNT(j)]); sum += c; cnt += (c > 0u) ? 1u : 0u; mine = (j == x) ? c : mine; }
        if (sum == G) break;
        __builtin_amdgcn_s_sleep(1);
        if ((++sp & 255u) == 0u) { if (xb_ld(&bar[XB_TMO])) break; if (sp > XB_SPIN_CAP) { atomicAdd(&bar[XB_TMO], 1u); break; } }
    }
    nloc = mine > 0u ? mine : 1u; nx = cnt > 0u ? cnt : 1u;
}

__device__ __forceinline__ void xcd_barrier(const XcdBarrier& b) {
    asm volatile("s_waitcnt vmcnt(0)" ::: "memory");
    __syncthreads();
    if (threadIdx.x == 0) {
        unsigned* bar = b.bar;
        __builtin_amdgcn_s_waitcnt(0);
        unsigned nloc = b.st[0], nx = b.st[1];
        if (nloc == 0u) { xcd_barrier_complete(bar, b.x, nloc, nx); b.st[0] = nloc; b.st[1] = nx; }
        const unsigned old = xb_add(&bar[XB_XSUB(b.x)], 1u);
        const unsigned gen = old / nloc;
        if (old + 1u == (gen + 1u) * nloc) {
            __builtin_amdgcn_fence(__ATOMIC_RELEASE, "agent");
            asm volatile("s_waitcnt vmcnt(0)" ::: "memory");
            const unsigned og = xb_add(&bar[XB_TOP], 1u);
            const unsigned tg = og / nx;
            if (og + 1u == (tg + 1u) * nx) xb_add(&bar[XB_TOPGEN], 1u);
            else XB_SPIN(xb_ld(&bar[XB_TOPGEN]) == tg, bar);
            __builtin_amdgcn_fence(__ATOMIC_ACQUIRE, "agent");
            xb_add(&bar[XB_XGEN(b.x)], 1u);
            asm volatile("s_waitcnt vmcnt(0)" ::: "memory");
        } else {
            XB_SPIN(xb_ld(&bar[XB_XGEN(b.x)]) == gen, bar);
            __builtin_amdgcn_fence(__ATOMIC_ACQUIRE, "agent");
            asm volatile("s_waitcnt vmcnt(0)" ::: "memory");
        }
    }
    __syncthreads();
}

__global__ void __launch_bounds__(512, 2) mega_fwd(Params parg) {
    extern __shared__ __attribute__((aligned(16))) unsigned char lds_raw[];
    LAS unsigned char* lds = (LAS unsigned char*)lds_raw;
    cg::grid_group grid = cg::this_grid();
    const int tid0 = threadIdx.x, wave = __builtin_amdgcn_readfirstlane(tid0 >> 6);
    const int G = gridDim.x, bx = blockIdx.x;
    const int vcu = (G % 8 == 0) ? (bx % 8) * (G / 8) + bx / 8 : bx;
    const int gw = vcu * 8 + wave, NGW = G * 8;
    const KP kp0 = (KP)__builtin_amdgcn_kernarg_segment_ptr();
    volatile LAS unsigned* barst = (volatile LAS unsigned*)(lds + LDS_BARST);
    if (tid0 < 2) barst[tid0] = 0u;
    __syncthreads();
    XcdBarrier xbar = xcd_barrier_post((unsigned*)(kp0->ws + A_BAR), barst);
    const int ph_lo = parg.ph_lo, ph_hi = parg.ph_hi;
    const float QSC64 = 0.125f * LOG2E, QSC256 = 0.0625f * LOG2E;

    for (int ph = ph_lo; ph < ph_hi; ++ph) {
        const int layer = ph >= 10 ? 1 : 0;
#pragma unroll 1
        for (int rep = 0; rep < ((ph == REPEAT_PH) ? 2 : 1); ++rep) {
        int tid = tid0; asm volatile("" : "+v"(tid));
        const int lane = tid & 63;
        KP p = kp0; asm volatile("" : "+s"(p));
        unsigned char* ws = p->ws;
        bf16_t* HB = (bf16_t*)(ws + A_HB); float* slots = (float*)(ws + A_SLOT);
        if (PH_ON(0) && ph == 0) {
            phase_prologue(p, lds, tid, lane, wave, gw, NGW, G);
        } else if (PH_ON(1) && (ph == 1 || ph == 10 || ph == 5 || ph == 13)) {
            { const int cb = (G == 256) ? bx - 224 : bx;
              if (ph == 1 && cb >= 0 && cb < 32 && wave == 0) cumsum_row((float*)(ws + A_LF) + (size_t)cb * SEQ, lane); }
            pg8::Gemm g; EpiScale<0> E;
            if (ph == 1)       { g = pg8::Gemm{HB, (const bf16_t*)(ws + W_INE), M, EINP, D}; E = EpiScale<0>{(bf16_t*)(ws + A_Z), EINP, slots, QSC64, 4, 6}; }
            else if (ph == 10) { g = pg8::Gemm{HB, (const bf16_t*)(ws + W_INO), M, OIN, D};  E = EpiScale<0>{(bf16_t*)(ws + A_Z), OIN, slots, QSC64, 0, 4}; }
            else               { g = pg8::Gemm{HB, (const bf16_t*)(ws + W_Q + layer * 2 * MiB), M, D, D}; E = EpiScale<0>{(bf16_t*)(ws + A_XQ), D, slots, QSC256, 0, 4}; }
            pg8::StaticOrder S; S.init(g.M, g.N, G, bx);
            if ((ph == 5 || ph == 13) && G == 256) {
                pg8::Unit u; S.next(0, u);
                g.Bt = (const bf16_t*)p->out + (size_t)(layer * 4 + (u.pm >> 4)) * D * D;
                EpiSoftmaxP EP{slots, QSC256, (bf16_t*)(ws + A_XO)};
                pg8::gemm_phase<EpiSoftmaxP, pg8::StaticOrder, false, true>(lds, g, S, EP);
            } else {
            pg8::gemm_phase<EpiScale<0>, pg8::StaticOrder, true, true>(lds, g, S, E);
            if (ph == 5 || ph == 13) {
                asm volatile("s_waitcnt vmcnt(0)" ::: "memory"); __syncthreads();
                pg8::Unit u;
                for (int i = 0; S.next(i, u); ++i) xattn_unit((const bf16_t*)(ws + A_XQ), (const bf16_t*)(ws + A_KV + layer * 4 * MiB), (bf16_t*)(ws + A_XO), u.pm, u.pn, lds, tid, lane, wave);
            }
            }
            if (ph == 1 && G == 256 && bx >= 192) {
                asm volatile("s_waitcnt vmcnt(0)" ::: "memory"); __syncthreads();
                transpose_group(p, ws, (LAS float*)(lds + wave * 8704), lane, 2 + 8, (bx - 192) * 8 + wave, 512);
            }
            if (ph == 1) {
                int l0 = 0, l1 = 2, c = bx;
                if (G == 256) { const int cc = bx - 128; if (cc >= 0 && cc < 64) { l0 = cc >> 5; l1 = l0 + 1; c = cc & 31; } else l1 = 0; }
                for (int l = l0; l < l1; ++l) {
                    pg8::Gemm g2{(const bf16_t*)(ws + A_MEMN), (const bf16_t*)(ws + W_KV + l * 4 * MiB), MMEM, 2 * D, D};
                    EpiScale<0> E2{(bf16_t*)(ws + A_KV + l * 4 * MiB), 2 * D, nullptr, 1.f, 0, 0};
                    pg8::StaticOrder S2; S2.init(MMEM, 2 * D, G, c);
                    pg8::gemm_phase<EpiScale<0>, pg8::StaticOrder, true, true>(lds, g2, S2, E2);
                }
            }
        } else if (PH_ON(2) && ph == 2) {
            for (int tile = gw; tile < 2048; tile += NGW) lru_tile<1>(p, tile, (LAS float*)(lds + wave * 18176), lane);
            if (G == 256) transpose_group(p, ws, (LAS float*)(lds + wave * 18176), lane, 4 + 8, gw, NGW);
            if (G == 256) {
                bf16_t* WqN = (bf16_t*)p->out + (size_t)16 * MiB;
                for (int q4 = gw * 64 + lane; q4 < 2 * D * D / 4; q4 += NGW * 64) { const int e = q4 * 4, l = e >> 20, k = (e >> 10) & 1023;
                    const f32x4 w = *(const f32x4*)(p->in[24] + e); const float gk = p->in[5][l * D + k];
                    u32x2 o; o.x = pk2(w[0] * gk, w[1] * gk); o.y = pk2(w[2] * gk, w[3] * gk); *(u32x2*)(WqN + e) = o; }
            }
            {
                const bf16_t* Zk = (const bf16_t*)(ws + A_Z) + 1536 + lane * 8;
                if (G == 256) {
                    float mx2 = 0.f;
#pragma unroll
                    for (int k = 0; k < 8; ++k) {
                        const u32x4 kv = *(const u32x4*)(Zk + (size_t)(gw * 8 + k) * EINP); float n2 = 0.f;
#pragma unroll
                        for (int e = 0; e < 4; ++e) { const float a0 = __uint_as_float(kv[e] << 16), a1 = __uint_as_float(kv[e] & 0xffff0000u); n2 += a0 * a0 + a1 * a1; }
                        n2 += __shfl_xor(n2, 1); n2 += __shfl_xor(n2, 2); n2 += __shfl_xor(n2, 4);
                        mx2 = fmaxf(mx2, n2);
                    }
                    __syncthreads();
                    LAS float* kx = (LAS float*)lds;
                    if ((lane & 7) == 0) kx[wave * 8 + (lane >> 3)] = mx2;
                    __syncthreads();
                    if (wave == 0 && lane < 8) { float m8 = kx[lane];
#pragma unroll
                        for (int w = 1; w < 8; ++w) m8 = fmaxf(m8, kx[w * 8 + lane]);
                        atomicMax((unsigned*)(ws + A_KMAX) + ((gw * 8) >> 12) * 8 + lane, __float_as_uint(m8)); }
                } else {
                    for (int m = gw; m < M; m += NGW) {
                        const u32x4 kv = *(const u32x4*)(Zk + (size_t)m * EINP); float n2 = 0.f;
#pragma unroll
                        for (int e = 0; e < 4; ++e) { const float a0 = __uint_as_float(kv[e] << 16), a1 = __uint_as_float(kv[e] & 0xffff0000u); n2 += a0 * a0 + a1 * a1; }
                        n2 += __shfl_xor(n2, 1); n2 += __shfl_xor(n2, 2); n2 += __shfl_xor(n2, 4);
                        if ((lane & 7) == 0) atomicMax((unsigned*)(ws + A_KMAX) + (m >> 12) * 8 + (lane >> 3), __float_as_uint(n2));
                    }
                }
            }
        } else if (PH_ON(3) && ph == 3) {
            for (int r2 = 0; r2 < (REPEAT_PH == 31 ? 2 : 1); ++r2)
            for (int tile = gw; tile < 2048; tile += NGW) lru_tile<2>(p, tile, (LAS float*)(lds + wave * 18176), lane);
            __syncthreads();
            for (int r2 = 0; r2 < (REPEAT_PH == 32 ? 2 : 1); ++r2)
            for (int u = vcu; u < 256; u += G) { const int bh = u >> 3, s = u & 7; fox_unit(p, bh, 15 - s, lds, tid, lane, wave); fox_unit(p, bh, s, lds, tid, lane, wave); }
            if (G == 256) {
                __syncthreads();
                const int idx = bx >> 2, c = bx & 3, kind = idx >> 5, l = (idx >> 4) & 1, b = (idx >> 2) & 3, hh = idx & 3;
                bf16_t* OUT = (bf16_t*)p->out; const bf16_t* KVl = (const bf16_t*)(ws + A_KV + l * 4 * MiB) + (size_t)(b * 256) * 2048;
                pg8::Gemm g2; EpiScale<0> E2; pg8::StaticOrder S2;
                if (kind == 0) { g2 = pg8::Gemm{KVl + hh * 256, OUT + (size_t)16 * MiB + (size_t)l * D * D + hh * 256, 256, D, 256, 2048, D};
                    E2 = EpiScale<0>{OUT + (size_t)(l * 4 + b) * D * D + (size_t)(hh * 256) * D, D, nullptr, 1.f, 0, 0}; S2.init(256, D, 4, c); }
                else { g2 = pg8::Gemm{(const bf16_t*)(ws + W_O + l * 2 * MiB) + hh * 256, KVl + 1024 + hh * 256, D, 256, 256, D, 2048};
                    E2 = EpiScale<0>{OUT + (size_t)8 * MiB + (size_t)(l * 4 + b) * D * D + hh * 256, D, nullptr, 1.f, 0, 0}; S2.init(D, 256, 4, c); }
                pg8::gemm_phase<EpiScale<0>, pg8::StaticOrder, true, true>(lds, g2, S2, E2);
            }
        } else if (PH_ON(11) && ph == 11) {
            const float d1 = wave_sum(p->in[18][lane] * p->in[19][lane]), d2 = wave_sum(p->in[20][lane] * p->in[21][lane]);
            const float lam = __builtin_bit_cast(float, __builtin_amdgcn_readfirstlane(__builtin_bit_cast(int, __expf(d1) - __expf(d2) + (0.8f - 0.6f * 0.7408182206817179f))));
            for (int u = vcu; u < 256; u += G) { const int bh = u >> 3, s = u & 7; diff_unit(p, bh, 15 - s, lam, lds, tid, lane, wave); diff_unit(p, bh, s, lam, lds, tid, lane, wave); }
        } else if (PH_ON(4) && (ph == 4 || ph == 12 || ph == 7 || ph == 15 || ph == 9 || ph == 17)) {
            pg8::Gemm g; EpiRes E{nullptr, HB, slots};
            if (ph == 4)       g = pg8::Gemm{(const bf16_t*)(ws + A_Y), (const bf16_t*)(ws + W_OUTE), M, D, D};
            else if (ph == 12) g = pg8::Gemm{(const bf16_t*)(ws + A_Y), (const bf16_t*)(ws + W_OUTO), M, D, D};
            else if (ph == 7 || ph == 15) g = pg8::Gemm{(const bf16_t*)(ws + A_XO), (const bf16_t*)(ws + W_O + layer * 2 * MiB), M, D, D};
            else g = pg8::Gemm{(const bf16_t*)(ws + A_FF), (const bf16_t*)(ws + W_DN + layer * 8 * MiB), M, D, FF};
            pg8::StaticOrder S; S.init(g.M, g.N, G, bx);
            if ((ph == 7 || ph == 15) && G == 256) { pg8::Unit u; S.next(0, u); g.Bt = (const bf16_t*)p->out + (size_t)8 * MiB + (size_t)(layer * 4 + (u.pm >> 4)) * D * D; }
            if (ph == 17 && G == 256) {
                EpiResFinal EF{HB, p->out, p->in[3], slots, (unsigned*)(ws + A_BAR + 16384)};
                pg8::gemm_phase<EpiResFinal, pg8::StaticOrder, false, true>(lds, g, S, EF);
            } else
            pg8::gemm_phase<EpiRes, pg8::StaticOrder, true, true>(lds, g, S, E);
        } else if (ph == 6 || ph == 14) {
        } else if (false) {
            for (int u = vcu; u < 256; u += G) xattn_unit((const bf16_t*)(ws + A_XQ), (const bf16_t*)(ws + A_KV + layer * 4 * MiB), (bf16_t*)(ws + A_XO), u >> 2, u & 3, lds, tid, lane, wave);
        } else if (PH_ON(8) && (ph == 8 || ph == 16)) {
            pg8::Gemm g{HB, (const bf16_t*)(ws + W_UP + layer * 8 * MiB), M, FF, D}; EpiScale<1> E{(bf16_t*)(ws + A_FF), FF, slots, 1.f, 0, 0};
            pg8::StaticOrder S; S.init(M, FF, G, bx);
            pg8::gemm_phase<EpiScale<1>, pg8::StaticOrder, true, true>(lds, g, S, E);
        } else if (PH_ON(18) && ph == 18 && G != 256) {
            const f32x4* gr = (const f32x4*)p->in[3] + lane;
            for (int m = gw; m < M; m += NGW) {
                const f32x4* sp = (const f32x4*)(slots + (size_t)m * 16); const f32x4 a = sp[0], b = sp[1], c = sp[2], d = sp[3];
                const float ss = ((a[0] + a[1]) + (a[2] + a[3])) + ((b[0] + b[1]) + (b[2] + b[3])) + ((c[0] + c[1]) + (c[2] + c[3])) + ((d[0] + d[1]) + (d[2] + d[3]));
                const float rstd = rsqrtf(ss * (1.f / D) + EPS);
                const u32x2* hr = (const u32x2*)(HB + (size_t)m * D) + lane; f32x4* xr = (f32x4*)(p->out + (size_t)m * D) + lane;
#pragma unroll
                for (int j = 0; j < 4; ++j) { const u32x2 w = hr[64 * j]; const f32x4 v = (f32x4){__uint_as_float(w.x << 16), __uint_as_float(w.x & 0xffff0000u), __uint_as_float(w.y << 16), __uint_as_float(w.y & 0xffff0000u)};
                    xr[64 * j] = v * rstd * gr[64 * j]; }
            }
        }
        }
        if (ph + 1 < ph_hi && ph != 6 && ph != 14 && !(ph == 17 && G == 256)) { if (ph_hi > 1000) grid.sync();   else xcd_barrier(xbar); for (int xs = 0; xs < EXTRA_SYNC; ++xs) xcd_barrier(xbar); }
    }
}

extern "C" void kernel_launch(void* const* d_in, const int* in_sizes, int n_in, void* d_out, int out_size, void* d_ws, size_t ws_size, hipStream_t stream) {
    static int grid = 0;
    if (grid == 0) {
        int dev = 0, cus = 0, per_cu = 0;
        hipGetDevice(&dev);
        hipDeviceGetAttribute(&cus, hipDeviceAttributeMultiprocessorCount, dev);
        hipFuncSetAttribute((const void*)mega_fwd, hipFuncAttributeMaxDynamicSharedMemorySize, LDS_BYTES);
        hipOccupancyMaxActiveBlocksPerMultiprocessor(&per_cu, (const void*)mega_fwd, 512, LDS_BYTES);
        if (per_cu < 1) { fprintf(stderr, "kernel_launch: occupancy query says %d blocks per CU\n", per_cu); per_cu = 1; }
        if (per_cu > 1) per_cu = 1;
        grid = cus * per_cu;
        (void)hipGetLastError();
    }
    Params p{};
    for (int i = 0; i < 29; ++i) p.in[i] = (const float*)d_in[i];
    p.out = (float*)d_out; p.ws = (unsigned char*)d_ws;
#if MK_ONE_LAUNCH
    (void)hipMemsetAsync((unsigned char*)d_ws + A_BAR, 0, 32768 + 256, stream);
    p.ph_lo = 0; p.ph_hi = NPHASE;
    void* args[] = {&p};
    hipError_t e = hipLaunchCooperativeKernel((const void*)mega_fwd, dim3(grid), dim3(512), args, LDS_BYTES, stream);
    if (e != hipSuccess) fprintf(stderr, "cooperative launch failed: %s (grid %d)\n", hipGetErrorString(e), grid);
#else
    for (int ph = 0; ph < NPHASE; ++ph) { p.ph_lo = ph; p.ph_hi = ph + 1; hipLaunchKernelGGL(mega_fwd, dim3(grid), dim3(512), LDS_BYTES, stream, p); }
#endif
}
```
